# Optimizing an MI355X kernel written in HIP

```python
import math
import jax, jax.numpy as jnp
from jax import lax
import numpy as np

D_MODEL = 1024
BATCH = 2
SEQ = 8192
DEPTH = 4
DEC_BATCH = 128
DEC_SEQ = 4
PAST_LEN = 8192
PAGE_SIZE = 128

HEAD_DIM = 64
N_Q_HEADS = 12
N_KV_HEADS = 4
GQA_GROUP = N_Q_HEADS // N_KV_HEADS
WINDOW = 128
ROT_DIM = HEAD_DIM // 4
ROPE_THETA = 500000.0
MEM_HEADS = 4
N_MEM = 256
SG_WIDTH = N_Q_HEADS * HEAD_DIM
SG_GROUPS = 4
SG_GROUP_DIM = SG_WIDTH // SG_GROUPS
CHUNK = 128
MIX_WIDTH = SG_WIDTH + MEM_HEADS * HEAD_DIM
A_IN = N_Q_HEADS * HEAD_DIM + 2 * N_KV_HEADS * HEAD_DIM + MEM_HEADS * HEAD_DIM
B_IN = 2 * SG_WIDTH + MEM_HEADS * HEAD_DIM
N_A_LAYERS = (DEPTH + 1) // 2
N_B_LAYERS = DEPTH // 2
PEER_HEADS = 8
N_KEYS = 128
N_EXPERTS = N_KEYS * N_KEYS
PEER_TOPK = 16
PEER_KEY_DIM = 256
PEER_HALF = PEER_KEY_DIM // 2
PEER_BLOCK = 256
DN_ALPHA = (2.0 * DEPTH) ** 0.25
DN_BETA = (8.0 * DEPTH) ** -0.25
LN_EPS = 1e-5
ATTN_SCALE = HEAD_DIM ** -0.5
NEG = -1e30

kernel_name = "hybrid_swa_sink_gmlp_peer_decoder_step"


def layer_norm(x, g, b):
    xf = x.astype(jnp.float32)
    mu = jnp.mean(xf, -1, keepdims=True)
    var = jnp.mean(jnp.square(xf - mu), -1, keepdims=True)
    return ((xf - mu) * lax.rsqrt(var + LN_EPS) * g.astype(jnp.float32) + b.astype(jnp.float32)).astype(x.dtype)


def post_norm(x, sub, g, b):
    return layer_norm(DN_ALPHA * x + sub, g, b)


def partial_rope(x, pos):
    half = ROT_DIM // 2
    inv = ROPE_THETA ** (-jnp.arange(half, dtype=jnp.float32) * (2.0 / ROT_DIM))
    ang = pos.astype(jnp.float32)[:, None] * inv[None, :]
    cos = jnp.cos(ang)[:, None, :]
    sin = jnp.sin(ang)[:, None, :]
    xr = x[..., :ROT_DIM].astype(jnp.float32)
    x1, x2 = xr[..., :half], xr[..., half:]
    rot = jnp.concatenate([x1 * cos - x2 * sin, x2 * cos + x1 * sin], -1).astype(x.dtype)
    return jnp.concatenate([rot, x[..., ROT_DIM:]], -1)


def sink_softmax(s, sink_col):
    full = jnp.concatenate([s, jnp.broadcast_to(sink_col, s.shape[:-1] + (1,))], -1)
    return jax.nn.softmax(full, axis=-1)[..., :-1]


def project_a(x, pos, w_in):
    n, s = x.shape[:2]
    z = x @ w_in
    qd = N_Q_HEADS * HEAD_DIM
    kd = N_KV_HEADS * HEAD_DIM
    q = partial_rope(z[..., :qd].reshape(n, s, N_Q_HEADS, HEAD_DIM), pos)
    k = partial_rope(z[..., qd:qd + kd].reshape(n, s, N_KV_HEADS, HEAD_DIM), pos)
    v = z[..., qd + kd:qd + 2 * kd].reshape(n, s, N_KV_HEADS, HEAD_DIM)
    qm = z[..., qd + 2 * kd:].reshape(n, s, MEM_HEADS, HEAD_DIM)
    return q, k, v, qm


def swa_prompt(q, k, v, sink):
    n, s = q.shape[:2]
    nb = s // WINDOW
    qb = q.reshape(n, nb, WINDOW, N_KV_HEADS, GQA_GROUP, HEAD_DIM)
    kb = k.reshape(n, nb, WINDOW, N_KV_HEADS, HEAD_DIM)
    vb = v.reshape(n, nb, WINDOW, N_KV_HEADS, HEAD_DIM)
    prev = lambda t: jnp.concatenate([jnp.zeros_like(t[:, :1]), t[:, :-1]], axis=1)
    k2 = jnp.concatenate([prev(kb), kb], axis=2)
    v2 = jnp.concatenate([prev(vb), vb], axis=2)
    sc = jnp.einsum('bnqhgd,bnkhd->bnhgqk', qb, k2, preferred_element_type=jnp.float32) * ATTN_SCALE
    qi = jnp.arange(WINDOW)[:, None] + WINDOW
    ki = jnp.arange(2 * WINDOW)[None, :]
    allowed = (ki <= qi) & (qi - ki < WINDOW)
    blk_ok = (jnp.arange(nb)[:, None, None] > 0) | (ki[None] >= WINDOW)
    mask = allowed[None] & blk_ok
    sc = jnp.where(mask[None, :, None, None], sc, NEG)
    p = sink_softmax(sc, sink.astype(jnp.float32).reshape(N_KV_HEADS, GQA_GROUP)[:, :, None, None])
    o = jnp.einsum('bnhgqk,bnkhd->bnqhgd', p.astype(v.dtype), v2)
    return o.reshape(n, s, N_Q_HEADS * HEAD_DIM)


def swa_sample(q, k_new, v_new, k_buf, v_buf, sink):
    n, t = q.shape[:2]
    wb = k_buf.shape[1]
    k_all = jnp.concatenate([k_buf, k_new], axis=1)
    v_all = jnp.concatenate([v_buf, v_new], axis=1)
    qg = q.reshape(n, t, N_KV_HEADS, GQA_GROUP, HEAD_DIM)
    sc = jnp.einsum('bqhgd,bkhd->bhgqk', qg, k_all, preferred_element_type=jnp.float32) * ATTN_SCALE
    q_pos = PAST_LEN + jnp.arange(t)
    k_pos = jnp.concatenate([PAST_LEN - wb + jnp.arange(wb), PAST_LEN + jnp.arange(t)])
    mask = (k_pos[None, :] <= q_pos[:, None]) & (q_pos[:, None] - k_pos[None, :] < WINDOW)
    sc = jnp.where(mask[None, None, None], sc, NEG)
    p = sink_softmax(sc, sink.astype(jnp.float32).reshape(N_KV_HEADS, GQA_GROUP)[:, :, None, None])
    o = jnp.einsum('bhgqk,bkhd->bqhgd', p.astype(v_all.dtype), v_all)
    return o.reshape(n, t, N_Q_HEADS * HEAD_DIM)


def spatial_gate(z, ln_g, ln_b, w_s, b_s, L):
    u = jax.nn.gelu(z[..., :SG_WIDTH], approximate=False)
    v = layer_norm(jax.nn.gelu(z[..., SG_WIDTH:], approximate=False), ln_g, ln_b)
    n, s = z.shape[:2]
    vc = v.reshape(n, s // L, L, SG_GROUPS, SG_GROUP_DIM)
    w = jnp.where(jnp.tril(jnp.ones((L, L), dtype=bool)), w_s[:, :L, :L], 0)
    sg = jnp.einsum('gts,bcsgd->bctgd', w, vc) + b_s[:, :L].T[:, :, None]
    return u * sg.reshape(n, s, SG_WIDTH), v


def mem_attend(q, mk, mv):
    n, s = q.shape[:2]
    sc = jnp.einsum('bqhd,bkhd->bhqk', q, mk, preferred_element_type=jnp.float32) * ATTN_SCALE
    p = jax.nn.softmax(sc, axis=-1)
    o = jnp.einsum('bhqk,bkhd->bqhd', p.astype(mv.dtype), mv)
    return o.reshape(n, s, MEM_HEADS * HEAD_DIM)


def peer(x, w_q, b_q, subkeys, u_tab, v_tab):
    shp = x.shape
    xt = x.reshape(-1, D_MODEL)
    ntok = xt.shape[0]
    nb = -(-ntok // PEER_BLOCK)
    xt = jnp.pad(xt, ((0, nb * PEER_BLOCK - ntok), (0, 0)))

    def block(xb):
        q = (xb @ w_q + b_q).reshape(-1, PEER_HEADS, 2, PEER_HALF)
        s = jnp.einsum('thcd,hcnd->thcn', q, subkeys, preferred_element_type=jnp.float32)
        sv, si = lax.top_k(s, PEER_TOPK)
        cand = (sv[:, :, 0, :, None] + sv[:, :, 1, None, :]).reshape(-1, PEER_HEADS, PEER_TOPK * PEER_TOPK)
        cid = (si[:, :, 0, :, None] * N_KEYS + si[:, :, 1, None, :]).reshape(-1, PEER_HEADS, PEER_TOPK * PEER_TOPK)
        fv, fi = lax.top_k(cand, PEER_TOPK)
        eid = jnp.take_along_axis(cid, fi, axis=-1)
        g = jax.nn.softmax(fv, axis=-1)
        ug = u_tab[eid]
        vg = v_tab[eid]
        h = jnp.einsum('td,thkd->thk', xb, ug, preferred_element_type=jnp.float32)
        a = (g * jax.nn.gelu(h, approximate=False)).astype(xb.dtype)
        return jnp.einsum('thk,thkd->td', a, vg)

    y = lax.map(block, xt.reshape(nb, PEER_BLOCK, D_MODEL))
    return y.reshape(-1, D_MODEL)[:ntok].reshape(shp)


def setup_inputs(seed: int = 0) -> dict:
    key = jax.random.key(seed)
    ks = jax.random.split(key, 28)
    f32 = jnp.float32
    nrm = lambda k, shape, scale: jax.random.normal(k, shape, f32) * scale
    win_buf = min(WINDOW, PAST_LEN)
    fan = D_MODEL ** -0.5
    a_cols = jnp.concatenate([
        jnp.full((N_Q_HEADS * HEAD_DIM + N_KV_HEADS * HEAD_DIM,), fan, f32),
        jnp.full((N_KV_HEADS * HEAD_DIM,), fan * DN_BETA, f32),
        jnp.full((MEM_HEADS * HEAD_DIM,), fan, f32)])
    mem_cols = jnp.concatenate([
        jnp.full((MEM_HEADS * HEAD_DIM,), fan, f32),
        jnp.full((MEM_HEADS * HEAD_DIM,), fan * DN_BETA, f32)])
    return {
        "x_prompt": nrm(ks[0], (BATCH, SEQ, D_MODEL), 1.0),
        "x_sample": nrm(ks[1], (DEC_BATCH, DEC_SEQ, D_MODEL), 1.0),
        "cache_swa_k": nrm(ks[2], (N_A_LAYERS, DEC_BATCH, win_buf, N_KV_HEADS, HEAD_DIM), 1.0),
        "cache_swa_v": nrm(ks[3], (N_A_LAYERS, DEC_BATCH, win_buf, N_KV_HEADS, HEAD_DIM), DN_BETA),
        "cache_mem_k": nrm(ks[4], (DEPTH, DEC_BATCH, N_MEM, MEM_HEADS, HEAD_DIM), 1.0),
        "cache_mem_v": nrm(ks[5], (DEPTH, DEC_BATCH, N_MEM, MEM_HEADS, HEAD_DIM), DN_BETA),
        "mem_prompt": nrm(ks[6], (BATCH, N_MEM, D_MODEL), 1.0),
        "a_w_in": nrm(ks[7], (N_A_LAYERS, D_MODEL, A_IN), 1.0) * a_cols,
        "a_sink": nrm(ks[8], (N_A_LAYERS, N_Q_HEADS), 1.0),
        "b_w_in": nrm(ks[9], (N_B_LAYERS, D_MODEL, B_IN), fan),
        "b_v_ln_g": 1.0 + nrm(ks[10], (N_B_LAYERS, SG_WIDTH), 0.02),
        "b_v_ln_b": nrm(ks[11], (N_B_LAYERS, SG_WIDTH), 0.02),
        "b_w_s": nrm(ks[12], (N_B_LAYERS, SG_GROUPS, CHUNK, CHUNK), CHUNK ** -0.5),
        "b_b_s": 1.0 + nrm(ks[13], (N_B_LAYERS, SG_GROUPS, CHUNK), 0.02),
        "w_mem_kv": nrm(ks[14], (DEPTH, D_MODEL, 2 * MEM_HEADS * HEAD_DIM), 1.0) * mem_cols,
        "w_out": nrm(ks[15], (DEPTH, MIX_WIDTH, D_MODEL), MIX_WIDTH ** -0.5 * DN_BETA),
        "ln1_g": 1.0 + nrm(ks[16], (DEPTH, D_MODEL), 0.02),
        "ln1_b": nrm(ks[17], (DEPTH, D_MODEL), 0.02),
        "ln2_g": 1.0 + nrm(ks[18], (DEPTH, D_MODEL), 0.02),
        "ln2_b": nrm(ks[19], (DEPTH, D_MODEL), 0.02),
        "peer_w_q": nrm(ks[20], (DEPTH, D_MODEL, PEER_HEADS * PEER_KEY_DIM), fan),
        "peer_b_q": nrm(ks[21], (DEPTH, PEER_HEADS * PEER_KEY_DIM), 0.01),
        "peer_subkeys": nrm(ks[22], (DEPTH, PEER_HEADS, 2, N_KEYS, PEER_HALF), PEER_HALF ** -0.5),
        "peer_u": nrm(ks[23], (DEPTH, N_EXPERTS, D_MODEL), fan),
        "peer_v": nrm(ks[24], (DEPTH, N_EXPERTS, D_MODEL), DN_BETA * PEER_HEADS ** -0.5),
    }


def reference(x_prompt, x_sample, cache_swa_k, cache_swa_v, cache_mem_k, cache_mem_v,
              mem_prompt, a_w_in, a_sink, b_w_in, b_v_ln_g, b_v_ln_b, b_w_s, b_b_s,
              w_mem_kv, w_out, ln1_g, ln1_b, ln2_g, ln2_b,
              peer_w_q, peer_b_q, peer_subkeys, peer_u, peer_v):
    n_p, seq = x_prompt.shape[:2]
    n_s, dec_seq = x_sample.shape[:2]
    pos_p = jnp.arange(seq, dtype=jnp.int32)
    pos_s = PAST_LEN + jnp.arange(dec_seq, dtype=jnp.int32)
    xp, xs = x_prompt, x_sample
    swa_kp, swa_vp, swa_ks, swa_vs, sg_vs, mem_kp, mem_vp = [], [], [], [], [], [], []
    for i in range(DEPTH):
        j = i // 2
        mkv = jnp.einsum('bmd,de->bme', mem_prompt, w_mem_kv[i]).reshape(n_p, N_MEM, 2, MEM_HEADS, HEAD_DIM)
        mk_p, mv_p = mkv[:, :, 0], mkv[:, :, 1]
        mem_kp.append(mk_p)
        mem_vp.append(mv_p)
        if i % 2 == 0:
            qp, kp, vp, qmp = project_a(xp, pos_p, a_w_in[j])
            qs, ks_, vs_, qms = project_a(xs, pos_s, a_w_in[j])
            tok_p = swa_prompt(qp, kp, vp, a_sink[j])
            tok_s = swa_sample(qs, ks_, vs_, cache_swa_k[j], cache_swa_v[j], a_sink[j])
            swa_kp.append(kp[:, -WINDOW:])
            swa_vp.append(vp[:, -WINDOW:])
            swa_ks.append(ks_)
            swa_vs.append(vs_)
        else:
            zp = xp @ b_w_in[j]
            zs = xs @ b_w_in[j]
            tok_p, _ = spatial_gate(zp[..., :2 * SG_WIDTH], b_v_ln_g[j], b_v_ln_b[j], b_w_s[j], b_b_s[j], CHUNK)
            tok_s, v_s = spatial_gate(zs[..., :2 * SG_WIDTH], b_v_ln_g[j], b_v_ln_b[j], b_w_s[j], b_b_s[j], dec_seq)
            sg_vs.append(v_s)
            qmp = zp[..., 2 * SG_WIDTH:].reshape(n_p, seq, MEM_HEADS, HEAD_DIM)
            qms = zs[..., 2 * SG_WIDTH:].reshape(n_s, dec_seq, MEM_HEADS, HEAD_DIM)
        mix_p = jnp.concatenate([tok_p, mem_attend(qmp, mk_p, mv_p)], axis=-1)
        mix_s = jnp.concatenate([tok_s, mem_attend(qms, cache_mem_k[i], cache_mem_v[i])], axis=-1)
        xp = post_norm(xp, mix_p @ w_out[i], ln1_g[i], ln1_b[i])
        xs = post_norm(xs, mix_s @ w_out[i], ln1_g[i], ln1_b[i])
        xp = post_norm(xp, peer(xp, peer_w_q[i], peer_b_q[i], peer_subkeys[i], peer_u[i], peer_v[i]), ln2_g[i], ln2_b[i])
        xs = post_norm(xs, peer(xs, peer_w_q[i], peer_b_q[i], peer_subkeys[i], peer_u[i], peer_v[i]), ln2_g[i], ln2_b[i])
    return (xp, xs, jnp.stack(swa_kp), jnp.stack(swa_vp), jnp.stack(swa_ks), jnp.stack(swa_vs),
            jnp.stack(sg_vs), jnp.stack(mem_kp), jnp.stack(mem_vp))
```

```cpp
#include <hip/hip_runtime.h>
#include <hip/hip_cooperative_groups.h>
#include <stdint.h>
#include <cstdio>
namespace cg = cooperative_groups;

#ifndef MK_MULTI
#define MK_MULTI 0
#endif

typedef unsigned short u16;
typedef __attribute__((ext_vector_type(8))) short bf16x8;
typedef __attribute__((ext_vector_type(4))) float f32x4;
typedef __attribute__((ext_vector_type(2))) float f32x2;
typedef __attribute__((ext_vector_type(4))) unsigned int u32x4;
typedef __attribute__((ext_vector_type(2))) unsigned int u32x2;
typedef __attribute__((ext_vector_type(6))) unsigned int u32x6;
typedef __attribute__((ext_vector_type(16))) float f32x16;
typedef __attribute__((ext_vector_type(32))) float f32x32;

#define T_P 16384
#define T_ALL 16896
#define ZLD 1792
#define SMEM_BYTES 73728
#define DN_ALPHA_F 1.6817928305074292f
#define LN_EPS_F 1e-5f
#define N_PHASES 25
#define PEER_SU 48.0f
#define PEER_SV 12.0f
#ifndef PROBE_MASK
#define PROBE_MASK 0u
#endif

struct Params {
  const float *x_prompt, *x_sample, *cache_swa_k, *cache_swa_v, *cache_mem_k, *cache_mem_v, *mem_prompt;
  const float *a_w_in, *a_sink, *b_w_in, *b_v_ln_g, *b_v_ln_b, *b_w_s, *b_b_s, *w_mem_kv, *w_out;
  const float *ln1_g, *ln1_b, *ln2_g, *ln2_b, *peer_w_q, *peer_b_q, *peer_subkeys, *peer_u, *peer_v;
  float *y_out, *swa_k_prompt, *swa_v_prompt, *swa_k_sample, *swa_v_sample, *sg_v_sample, *mem_k_prompt, *mem_v_prompt;
  u16 *wT_a_in, *wT_b_in, *wT_memkv, *wT_out, *wT_pq, *subk, *memb, *xb, *z, *mix, *mkvp;
  unsigned char *ub, *vb;
  float *xf, *pre, *ropecs;
  uint32_t *topk;
  unsigned *bar;
};

typedef const __attribute__((address_space(4))) Params* PP;

__constant__ double c_rope_inv[8] = {1.0, 0.19392274474868576, 0.03760603093086393, 0.007292664737217109,
  0.001414213562373095, 0.0002742481756762073, 5.318295896944988e-05, 1.031338537721246e-05};
__constant__ unsigned char c_cand[64] = {
  0x00,0x01,0x02,0x03,0x04,0x05,0x06,0x07,0x08,0x09,0x0a,0x0b,0x0c,0x0d,0x0e,0x0f,0x10,0x11,0x12,0x13,0x14,0x15,0x16,0x17,
  0x20,0x21,0x22,0x23,0x24,0x30,0x31,0x32,0x33,0x40,0x41,0x42,0x50,0x51,0x60,0x61,0x70,0x71,0x80,0x90,0xa0,0xb0,0xc0,0xd0,
  0xe0,0xf0,0,0,0,0,0,0,0,0,0,0,0,0,0,0};

__device__ __forceinline__ int tid_opaque() { int t = threadIdx.x; asm volatile("" : "+v"(t)); return t; }
__device__ __forceinline__ int bid_opaque() { int b = blockIdx.x; asm volatile("" : "+s"(b)); return b; }
__device__ __forceinline__ u32x4 zero4() { uint32_t z = 0; asm volatile("" : "+v"(z)); return u32x4{z, z, z, z}; }
__device__ __forceinline__ uint32_t pack_bf16(float a, float b) {
  uint32_t ua = __float_as_uint(a), ub = __float_as_uint(b);
  ua += 0x7FFFu + ((ua >> 16) & 1u);
  ub += 0x7FFFu + ((ub >> 16) & 1u);
  return (ua >> 16) | (ub & 0xFFFF0000u);
}
__device__ __forceinline__ u16 f2bf(float a) {
  uint32_t ua = __float_as_uint(a);
  ua += 0x7FFFu + ((ua >> 16) & 1u);
  return (u16)(ua >> 16);
}
__device__ __forceinline__ float bf2f(u16 h) { return __uint_as_float(((uint32_t)h) << 16); }
__device__ __forceinline__ float bflo(uint32_t w) { return __uint_as_float(w << 16); }
__device__ __forceinline__ float bfhi(uint32_t w) { return __uint_as_float(w & 0xFFFF0000u); }
__device__ __forceinline__ float gelu_exact(float x) { return 0.5f * x * (1.0f + erff(x * 0.70710678118654752f)); }
__device__ __forceinline__ u32x4 cvt8(f32x4 a, f32x4 b) {
  u32x4 o; o.x = pack_bf16(a.x, a.y); o.y = pack_bf16(a.z, a.w); o.z = pack_bf16(b.x, b.y); o.w = pack_bf16(b.z, b.w); return o;
}
__device__ __forceinline__ bf16x8 as_frag(u32x4 v) { union { u32x4 u; bf16x8 f; } c; c.u = v; return c.f; }
__device__ __forceinline__ float wave_sum(float v) {
#pragma unroll
  for (int o = 32; o >= 1; o >>= 1) v += __shfl_xor(v, o);
  return v;
}

__device__ __forceinline__ void stage_half(const u16* __restrict__ base, int ld, unsigned char* dst, int tid) {
#pragma unroll
  for (int i = 0; i < 4; i++) {
    const int b = tid * 16 + i * 4096;
    const int st = b >> 10, sb = b & 1023, swz = sb ^ (((sb >> 9) & 1) << 5);
    const int R = (st >> 1) * 16 + (swz >> 6), C = (st & 1) * 32 + ((swz & 63) >> 1);
    __builtin_amdgcn_global_load_lds((const unsigned*)(base + (size_t)R * ld + C), (unsigned*)(dst + b), 16, 0, 0);
  }
}
#define WAIT_VM(n) asm volatile("s_waitcnt vmcnt(" #n ")" ::: "memory")

__device__ __forceinline__ void gemm128(const u16* __restrict__ A, int lda, const u16* __restrict__ Bt, int ldb, int K,
                                        u16* lds, f32x4 (&acc)[4][4]) {
  const int tid = tid_opaque(), lane = tid & 63, w = tid >> 6;
  const int wm = w >> 1, wn = w & 1, fr = lane & 15, fq = lane >> 4;
#pragma unroll
  for (int i = 0; i < 4; i++)
#pragma unroll
    for (int j = 0; j < 4; j++) acc[i][j] = f32x4{0.f, 0.f, 0.f, 0.f};
  unsigned char* L = (unsigned char*)lds;
  const int nk = K >> 6;
  stage_half(A, lda, L, tid);
  stage_half(Bt, ldb, L + 16384, tid);
  stage_half(A + 64, lda, L + 32768, tid);
  stage_half(Bt + 64, ldb, L + 49152, tid);
  const int laneoff = fr * 64 + ((fq ^ ((fr >> 3) << 1)) << 4);
  const unsigned char* rA = L + wm * 8192 + laneoff;
  const unsigned char* rB = L + 16384 + wn * 8192 + laneoff;
  for (int kt = 0; kt < nk; kt++) {
    const int cur = (kt & 1) * 32768;
    if (kt + 1 < nk) WAIT_VM(8); else WAIT_VM(0);
    __builtin_amdgcn_s_barrier();
    asm volatile("" ::: "memory");
#pragma unroll
    for (int ks = 0; ks < 2; ks++) {
      bf16x8 af[4], bfr[4];
#pragma unroll
      for (int i = 0; i < 4; i++) af[i] = *(const bf16x8*)(rA + cur + (i * 2 + ks) * 1024);
#pragma unroll
      for (int j = 0; j < 4; j++) bfr[j] = *(const bf16x8*)(rB + cur + (j * 2 + ks) * 1024);
#pragma unroll
      for (int i = 0; i < 4; i++)
#pragma unroll
        for (int j = 0; j < 4; j++) acc[i][j] = __builtin_amdgcn_mfma_f32_16x16x32_bf16(af[i], bfr[j], acc[i][j], 0, 0, 0);
    }
    asm volatile("s_waitcnt lgkmcnt(0)" ::: "memory");
    __builtin_amdgcn_s_barrier();
    asm volatile("" ::: "memory");
    if (kt + 2 < nk) {
      stage_half(A + (kt + 2) * 64, lda, L + cur, tid);
      stage_half(Bt + (kt + 2) * 64, ldb, L + cur + 16384, tid);
    }
  }
  __syncthreads();
}

__device__ __forceinline__ void transpose_tile(const float* __restrict__ src, u16* __restrict__ dst, int K, int N, int k0, int n0, float* tl) {
  const int tid = tid_opaque();
#pragma unroll
  for (int i = 0; i < 4; i++) {
    int r = (tid >> 4) + i * 16, c = (tid & 15) * 4;
    f32x4 v = *(const f32x4*)(src + (size_t)(k0 + r) * N + n0 + c);
    tl[r * 65 + c] = v.x; tl[r * 65 + c + 1] = v.y; tl[r * 65 + c + 2] = v.z; tl[r * 65 + c + 3] = v.w;
  }
  __syncthreads();
  const int n = tid >> 2, kc = (tid & 3) * 16;
  uint32_t o[8];
#pragma unroll
  for (int e = 0; e < 8; e++) o[e] = pack_bf16(tl[(kc + 2 * e) * 65 + n], tl[(kc + 2 * e + 1) * 65 + n]);
  u32x4* d = (u32x4*)(dst + (size_t)(n0 + n) * K + k0 + kc);
  d[0] = u32x4{o[0], o[1], o[2], o[3]};
  d[1] = u32x4{o[4], o[5], o[6], o[7]};
  __syncthreads();
}

__device__ __forceinline__ void convert_span(const float* __restrict__ s, u16* __restrict__ d, float* __restrict__ fcopy, size_t n8) {
  const size_t stride = (size_t)gridDim.x * 256;
  for (size_t g0 = (size_t)bid_opaque() * 256 + tid_opaque(); g0 < n8; g0 += stride * 4) {
    f32x4 a[4], b[4];
#pragma unroll
    for (int u = 0; u < 4; u++) {
      const size_t g = g0 + u * stride;
      if (g < n8) { a[u] = ((const f32x4*)s)[2 * g]; b[u] = ((const f32x4*)s)[2 * g + 1]; }
    }
#pragma unroll
    for (int u = 0; u < 4; u++) {
      const size_t g = g0 + u * stride;
      if (g < n8) {
        ((u32x4*)d)[g] = cvt8(a[u], b[u]);
        if (fcopy) { ((f32x4*)fcopy)[2 * g] = a[u]; ((f32x4*)fcopy)[2 * g + 1] = b[u]; }
      }
    }
  }
}
__device__ __forceinline__ void convert_span_fp6(const float* __restrict__ s, unsigned char* __restrict__ d, size_t gbeg, size_t n32, float sc) {
  const size_t stride = (size_t)gridDim.x * 256;
  for (size_t g0 = gbeg + (size_t)bid_opaque() * 256 + tid_opaque(); g0 < n32; g0 += stride * 2) {
    f32x4 a[2][8];
#pragma unroll
    for (int u = 0; u < 2; u++) {
      const size_t g = g0 + u * stride;
      if (g < n32) {
#pragma unroll
        for (int q = 0; q < 8; q++) a[u][q] = __builtin_nontemporal_load(((const f32x4*)s) + 8 * g + q);
      }
    }
#pragma unroll
    for (int u = 0; u < 2; u++) {
      const size_t g = g0 + u * stride;
      if (g < n32) {
        f32x16 lo, hi;
#pragma unroll
        for (int q = 0; q < 4; q++)
#pragma unroll
          for (int e = 0; e < 4; e++) {
            const int idx = q * 4 + e;
            lo[idx] = a[u][idx >> 1][(idx & 1) * 2] * sc; hi[idx] = a[u][idx >> 1][(idx & 1) * 2 + 1] * sc;
          }
        const u32x6 pk = __builtin_amdgcn_cvt_scalef32_2xpk16_fp6_f32(lo, hi, 1.0f);
        u32x2* dp = (u32x2*)(d + (g >> 5) * 1280 + (g & 31) * 24);
        dp[0] = u32x2{pk[0], pk[1]}; dp[1] = u32x2{pk[2], pk[3]}; dp[2] = u32x2{pk[4], pk[5]};
      }
    }
  }
}

__device__ __forceinline__ void convert_span_fp4(const float* __restrict__ s, unsigned char* __restrict__ d, size_t gbeg, size_t n32, float sc) {
  const size_t stride = (size_t)gridDim.x * 256;
  for (size_t g0 = gbeg + (size_t)bid_opaque() * 256 + tid_opaque(); g0 < n32; g0 += stride * 2) {
    f32x4 a[2][8];
#pragma unroll
    for (int u = 0; u < 2; u++) {
      const size_t g = g0 + u * stride;
      if (g < n32) {
#pragma unroll
        for (int q = 0; q < 8; q++) a[u][q] = __builtin_nontemporal_load(((const f32x4*)s) + 8 * g + q);
      }
    }
#pragma unroll
    for (int u = 0; u < 2; u++) {
      const size_t g = g0 + u * stride;
      if (g < n32) {
        u32x4 o;
#pragma unroll
        for (int wd = 0; wd < 4; wd++) {
          unsigned wv = 0;
          wv = __builtin_amdgcn_cvt_scalef32_pk_fp4_f32(wv, a[u][2 * wd].x * sc, a[u][2 * wd].y * sc, 1.0f, 0);
          wv = __builtin_amdgcn_cvt_scalef32_pk_fp4_f32(wv, a[u][2 * wd].z * sc, a[u][2 * wd].w * sc, 1.0f, 1);
          wv = __builtin_amdgcn_cvt_scalef32_pk_fp4_f32(wv, a[u][2 * wd + 1].x * sc, a[u][2 * wd + 1].y * sc, 1.0f, 2);
          wv = __builtin_amdgcn_cvt_scalef32_pk_fp4_f32(wv, a[u][2 * wd + 1].z * sc, a[u][2 * wd + 1].w * sc, 1.0f, 3);
          o[wd] = wv;
        }
        *(u32x4*)(d + (g >> 5) * 1280 + 768 + (g & 31) * 16) = o;
      }
    }
  }
}

__device__ __forceinline__ int xcd_tile(int t, int ntiles) { return (t & 7) * (ntiles >> 3) + (t >> 3); }

__device__ __forceinline__ void convert_tables_part(PP p, int layer, int part) {
  const size_t lo = part == 0 ? 0 : (part == 1 ? 174763 : 349526), hi = part == 0 ? 174763 : (part == 1 ? 349526 : 524288);
  const size_t g0 = (size_t)layer * 524288 + lo;
  convert_span_fp6(p->peer_u, p->ub, g0, g0 + (hi - lo), PEER_SU);
  convert_span_fp4(p->peer_v, p->ub, g0, g0 + (hi - lo), PEER_SV);
}

__device__ __forceinline__ void phase_prologue(PP p, unsigned char* smem) {
  float* tl = (float*)smem;
  for (int t = bid_opaque(); t < 5248; t += gridDim.x) {
    const float* src; u16* dst; int N, tt;
    if (t < 768) { tt = t; N = 1536; src = p->a_w_in; dst = p->wT_a_in; }
    else if (t < 1664) { tt = t - 768; N = 1792; src = p->b_w_in; dst = p->wT_b_in; }
    else if (t < 2176) { tt = t - 1664; N = 512; src = p->w_mem_kv; dst = p->wT_memkv; }
    else if (t < 3200) { tt = t - 2176; N = 1024; src = p->w_out; dst = p->wT_out; }
    else { tt = t - 3200; N = 2048; src = p->peer_w_q; dst = p->wT_pq; }
    const int ntn = N >> 6, per = 16 * ntn;
    const int mat = tt / per, r = tt % per, kt = r / ntn, nt = r % ntn;
    transpose_tile(src + (size_t)mat * 1024 * N, dst + (size_t)mat * 1024 * N, 1024, N, kt * 64, nt * 64, tl);
  }
  convert_span(p->peer_subkeys, p->subk, nullptr, 131072);
  convert_span(p->mem_prompt, p->memb, nullptr, 65536);
  convert_span(p->x_prompt, p->xb, p->xf, 2097152);
  convert_span(p->x_sample, p->xb + (size_t)T_P * 1024, p->xf + (size_t)T_P * 1024, 65536);
  for (int idx = bid_opaque() * 256 + tid_opaque(); idx < 8196 * 8; idx += gridDim.x * 256) {
    const int pos = idx >> 3, d = idx & 7;
    const double inv = c_rope_inv[d];
    double ang = (double)pos * inv;
    double n = rint(ang * 0.15915494309189535);
    double r = ang - n * 6.283185307179586476925;
    double r2 = r * r, ts = r, tc = 1.0, ss = r, cc = 1.0;
    for (int k = 0; k < 14; k++) {
      tc = -tc * r2 / (double)((2 * k + 1) * (2 * k + 2));
      ts = -ts * r2 / (double)((2 * k + 2) * (2 * k + 3));
      cc += tc; ss += ts;
    }
    p->ropecs[2 * idx] = (float)cc;
    p->ropecs[2 * idx + 1] = (float)ss;
  }
}

__device__ __forceinline__ void phase_inproj(PP p, int layer, unsigned char* smem) {
  const int jl = layer >> 1;
  const bool isA = !(layer & 1);
  const int NIN = isA ? 1536 : 1792, ntn = NIN >> 7;
  const u16* W = isA ? p->wT_a_in + (size_t)jl * 1536 * 1024 : p->wT_b_in + (size_t)jl * 1792 * 1024;
  const int ntiles = 132 * ntn, extra = (layer == 0) ? 64 : 0;
  const int tid = tid_opaque(), lane = tid & 63, w = tid >> 6, wm = w >> 1, wn = w & 1, quad = lane >> 4, lc = lane & 15;
  for (int t = bid_opaque(); t < ntiles + extra; t += gridDim.x) {
    f32x4 acc[4][4];
    if (t < ntiles) {
      const int tx = xcd_tile(t, ntiles);
      const int tm = tx / ntn, tn = tx % ntn;
      gemm128(p->xb + (size_t)tm * 128 * 1024, 1024, W + (size_t)tn * 128 * 1024, 1024, 1024, (u16*)smem, acc);
      const int rb = tm * 128 + wm * 64, cb = tn * 128 + wn * 64;
      u16* Cs = (u16*)smem;
      if (isA && tn < 8) {
        f32x2 cs[4][4];
#pragma unroll
        for (int i = 0; i < 4; i++)
#pragma unroll
          for (int r = 0; r < 4; r++) {
            const int row = rb + i * 16 + quad * 4 + r;
            const int pos = row < T_P ? (row & 8191) : 8192 + ((row - T_P) & 3);
            cs[i][r] = *(const f32x2*)(p->ropecs + (size_t)(pos * 8 + (lc & 7)) * 2);
          }
#pragma unroll
        for (int i = 0; i < 4; i++)
#pragma unroll
          for (int r = 0; r < 4; r++) {
            const float v = acc[i][0][r];
            const float partner = __shfl_xor(v, 8);
            acc[i][0][r] = (lc < 8) ? (v * cs[i][r].x - partner * cs[i][r].y) : (v * cs[i][r].x + partner * cs[i][r].y);
          }
      }
      if (!isA && tn < 12) {
#pragma unroll
        for (int i = 0; i < 4; i++)
#pragma unroll
          for (int j = 0; j < 4; j++)
#pragma unroll
            for (int r = 0; r < 4; r++) acc[i][j][r] = gelu_exact(acc[i][j][r]);
      }
#pragma unroll
      for (int i = 0; i < 4; i++)
#pragma unroll
        for (int j = 0; j < 4; j++)
#pragma unroll
          for (int r = 0; r < 4; r++) Cs[(wm * 64 + i * 16 + quad * 4 + r) * 136 + wn * 64 + j * 16 + lc] = f2bf(acc[i][j][r]);
      if (isA && tn >= 6 && tn < 10) {
        float* okp = (tn < 8) ? p->swa_k_prompt : p->swa_v_prompt;
        float* oks = (tn < 8) ? p->swa_k_sample : p->swa_v_sample;
        const int cko = (tn < 8) ? 768 : 1024;
#pragma unroll
        for (int i = 0; i < 4; i++)
#pragma unroll
          for (int r = 0; r < 4; r++) {
            const int row = rb + i * 16 + quad * 4 + r;
            float* dst = nullptr;
            if (row < T_P) {
              const int b = row >> 13, s2 = row & 8191;
              if (s2 >= 8064) dst = okp + ((size_t)(jl * 2 + b) * 128 + (s2 - 8064)) * 256;
            } else {
              dst = oks + ((size_t)jl * 512 + (row - T_P)) * 256;
            }
            if (dst) {
#pragma unroll
              for (int j = 0; j < 4; j++) dst[cb + j * 16 + lc - cko] = acc[i][j][r];
            }
          }
      }
      __syncthreads();
#pragma unroll
      for (int it = 0; it < 8; it++) {
        const int row = it * 16 + (tid >> 4), ch = tid & 15;
        *(u32x4*)(p->z + (size_t)(tm * 128 + row) * ZLD + tn * 128 + ch * 8) = *(const u32x4*)(Cs + row * 136 + ch * 8);
      }
      __syncthreads();
    } else {
      const int t2 = t - ntiles, l = t2 >> 4, tm = (t2 >> 2) & 3, tn = t2 & 3;
      gemm128(p->memb + (size_t)tm * 128 * 1024, 1024, p->wT_memkv + ((size_t)l * 512 + tn * 128) * 1024, 1024, 1024, (u16*)smem, acc);
      const int rb = tm * 128 + wm * 64, cb = tn * 128 + wn * 64;
#pragma unroll
      for (int i = 0; i < 4; i++)
#pragma unroll
        for (int j = 0; j < 4; j++)
#pragma unroll
          for (int r = 0; r < 4; r++) {
            const int row = rb + i * 16 + quad * 4 + r, col = cb + j * 16 + lc;
            const float v = acc[i][j][r];
            const int kv = col >> 8, c2 = col & 255;
            float* o = kv ? p->mem_v_prompt : p->mem_k_prompt;
            o[((size_t)l * 512 + row) * 256 + c2] = v;
            p->mkvp[((size_t)(l * 2 + kv) * 512 + row) * 256 + c2] = f2bf(v);
          }
    }
  }
  convert_tables_part(p, layer, 0);
}

template <int NK, bool SINK, int NSUB, class FK, class FV, class FQ, class FM, class FS, class FO>
__device__ __forceinline__ void attn_core(u16* lds, int nrows, FK loadK, FV loadV, FQ loadQ, FM allowed, FS sinkf, FO outp) {
  const int tid = tid_opaque(), lane = tid & 63, w = tid >> 6, quad = lane >> 4, lc = lane & 15;
  u16* Ks = lds;
  u16* Vt = lds + 256 * 72;
  {
    constexpr int NIT = NK * 8 / 256;
    u32x4 kreg[NIT], vreg[NIT];
#pragma unroll
    for (int it = 0; it < NIT; it++) {
      const int c = tid + it * 256, kk = c >> 3, ch = c & 7;
      kreg[it] = loadK(kk, ch);
      vreg[it] = loadV(kk, ch);
    }
#pragma unroll
    for (int it = 0; it < NIT; it++) {
      const int c = tid + it * 256, kk = c >> 3, ch = c & 7;
      *(u32x4*)(Ks + kk * 72 + ch * 8) = kreg[it];
      const u32x4 vv = vreg[it];
      u16* vd = Vt + (ch * 8) * 264 + kk;
      vd[0 * 264] = (u16)(vv.x & 0xFFFF); vd[1 * 264] = (u16)(vv.x >> 16);
      vd[2 * 264] = (u16)(vv.y & 0xFFFF); vd[3 * 264] = (u16)(vv.y >> 16);
      vd[4 * 264] = (u16)(vv.z & 0xFFFF); vd[5 * 264] = (u16)(vv.z >> 16);
      vd[6 * 264] = (u16)(vv.w & 0xFFFF); vd[7 * 264] = (u16)(vv.w >> 16);
    }
  }
  __syncthreads();
  const bool active = (w * 16 < nrows);
  constexpr int NT = NK / 16;
  if (active) {
    const int row = w * 16 + lc;
    bf16x8 qn0 = as_frag(loadQ(0, row, quad * 8)), qn1 = as_frag(loadQ(0, row, 32 + quad * 8));
#pragma unroll 1
    for (int sub = 0; sub < NSUB; sub++) {
      bf16x8 qf[1][2];
      qf[0][0] = qn0; qf[0][1] = qn1;
      if (sub + 1 < NSUB) { qn0 = as_frag(loadQ(sub + 1, row, quad * 8)); qn1 = as_frag(loadQ(sub + 1, row, 32 + quad * 8)); }
      f32x4 s[NT];
#pragma unroll
      for (int nt = 0; nt < NT; nt++) {
        s[nt] = f32x4{0.f, 0.f, 0.f, 0.f};
#pragma unroll
        for (int ks = 0; ks < 2; ks++) {
          const bf16x8 kf = *(const bf16x8*)(Ks + (nt * 16 + lc) * 72 + ks * 32 + quad * 8);
          s[nt] = __builtin_amdgcn_mfma_f32_16x16x32_bf16(kf, qf[0][ks], s[nt], 0, 0, 0);
        }
      }
      __builtin_amdgcn_sched_barrier(0);
      const float sk = SINK ? sinkf(sub, row) : -3.0e38f;
      float m = sk;
#pragma unroll
      for (int nt = 0; nt < NT; nt++)
#pragma unroll
        for (int r = 0; r < 4; r++) {
          const float v = allowed(sub, row, nt * 16 + quad * 4 + r) ? s[nt][r] * 0.125f : -1.0e30f;
          s[nt][r] = v;
          m = fmaxf(m, v);
        }
      m = fmaxf(m, __shfl_xor(m, 16)); m = fmaxf(m, __shfl_xor(m, 32));
      float sum = 0.f;
#pragma unroll
      for (int nt = 0; nt < NT; nt++)
#pragma unroll
        for (int r = 0; r < 4; r++) { const float e = __expf(s[nt][r] - m); s[nt][r] = e; sum += e; }
      sum += __shfl_xor(sum, 16); sum += __shfl_xor(sum, 32);
      if (SINK) sum += __expf(sk - m);
      const float inv = 1.0f / sum;
      __builtin_amdgcn_sched_barrier(0);
      f32x4 o[4];
#pragma unroll
      for (int dt = 0; dt < 4; dt++) o[dt] = f32x4{0.f, 0.f, 0.f, 0.f};
#pragma unroll
      for (int kk = 0; kk < NT / 2; kk++) {
        u32x4 pp;
        pp.x = pack_bf16(s[2 * kk][0] * inv, s[2 * kk][1] * inv); pp.y = pack_bf16(s[2 * kk][2] * inv, s[2 * kk][3] * inv);
        pp.z = pack_bf16(s[2 * kk + 1][0] * inv, s[2 * kk + 1][1] * inv); pp.w = pack_bf16(s[2 * kk + 1][2] * inv, s[2 * kk + 1][3] * inv);
        const bf16x8 pf = as_frag(pp);
#pragma unroll
        for (int dt = 0; dt < 4; dt++) {
          const u16* vr = Vt + (dt * 16 + lc) * 264 + kk * 32 + quad * 4;
          const u32x2 v0 = *(const u32x2*)vr, v1 = *(const u32x2*)(vr + 16);
          const bf16x8 vf = as_frag(u32x4{v0.x, v0.y, v1.x, v1.y});
          o[dt] = __builtin_amdgcn_mfma_f32_16x16x32_bf16(vf, pf, o[dt], 0, 0, 0);
        }
        __builtin_amdgcn_sched_barrier(0);
      }
      if (row < nrows) {
        u16* op = outp(sub, row);
#pragma unroll
        for (int dt = 0; dt < 4; dt++)
          *(u32x2*)(op + dt * 16 + quad * 4) = u32x2{pack_bf16(o[dt][0], o[dt][1]), pack_bf16(o[dt][2], o[dt][3])};
      }
    }
  }
  __syncthreads();
}

__device__ __forceinline__ u32x4 ld_f32x8_as_bf16(const float* ptr) {
  const f32x4 a = *(const f32x4*)ptr, b = *(const f32x4*)(ptr + 4);
  return cvt8(a, b);
}

__device__ __forceinline__ void sg_prompt_item(PP p, int jl, int item, unsigned char* smem) {
  const int tid = tid_opaque(), lane = tid & 63, w = tid >> 6, quad = lane >> 4, lc = lane & 15;
  float* stats = (float*)smem;
  float* lnp = (float*)(smem + 1024);
  u16* Vt = (u16*)(smem + 2560);
  const int tok0 = (item >> 2) * 128;
  const int g = item & 3;
  for (int bt = 0; bt < 4; bt++) {
    const int srow = w * 32 + bt * 8 + (lane >> 3);
    const u16* zr = p->z + (size_t)(tok0 + srow) * ZLD + 768 + (lane & 7) * 96;
    u32x4 q[12];
#pragma unroll
    for (int i = 0; i < 12; i++) q[i] = *(const u32x4*)(zr + i * 8);
    float sum = 0.f;
#pragma unroll
    for (int i = 0; i < 12; i++)
#pragma unroll
      for (int e = 0; e < 4; e++) sum += bflo(q[i][e]) + bfhi(q[i][e]);
    sum += __shfl_xor(sum, 1); sum += __shfl_xor(sum, 2); sum += __shfl_xor(sum, 4);
    const float mu = sum * (1.0f / 768.0f);
    float sq = 0.f;
#pragma unroll
    for (int i = 0; i < 12; i++)
#pragma unroll
      for (int e = 0; e < 4; e++) { const float d0 = bflo(q[i][e]) - mu, d1 = bfhi(q[i][e]) - mu; sq += d0 * d0 + d1 * d1; }
    sq += __shfl_xor(sq, 1); sq += __shfl_xor(sq, 2); sq += __shfl_xor(sq, 4);
    if ((lane & 7) == 0) { stats[srow * 2] = mu; stats[srow * 2 + 1] = rsqrtf(sq * (1.0f / 768.0f) + LN_EPS_F); }
  }
  if (tid < 192) { lnp[tid * 2] = p->b_v_ln_g[jl * 768 + g * 192 + tid]; lnp[tid * 2 + 1] = p->b_v_ln_b[jl * 768 + g * 192 + tid]; }
  __syncthreads();
  {
    {
      u32x4 q[12];
#pragma unroll
      for (int it = 0; it < 12; it++) {
        const int c2 = tid + it * 256, s2 = c2 / 24, ch = c2 % 24;
        q[it] = *(const u32x4*)(p->z + (size_t)(tok0 + s2) * ZLD + 768 + g * 192 + ch * 8);
      }
#pragma unroll
      for (int it = 0; it < 12; it++) {
        const int c2 = tid + it * 256, s2 = c2 / 24, ch = c2 % 24;
        const float mu = stats[s2 * 2], rs = stats[s2 * 2 + 1];
        const float* lp = lnp + ch * 16;
        u16* vd = Vt + (ch * 8) * 136 + s2;
#pragma unroll
        for (int e = 0; e < 4; e++) {
          vd[(2 * e) * 136] = f2bf((bflo(q[it][e]) - mu) * rs * lp[4 * e] + lp[4 * e + 1]);
          vd[(2 * e + 1) * 136] = f2bf((bfhi(q[it][e]) - mu) * rs * lp[4 * e + 2] + lp[4 * e + 3]);
        }
      }
    }
    __syncthreads();
    const float* wsg = p->b_w_s + (size_t)(jl * 4 + g) * 128 * 128;
    const float* bsg = p->b_b_s + (jl * 4 + g) * 128;
    for (int hh = 0; hh < 2; hh++) {
      f32x4 acc[2][6];
#pragma unroll
      for (int i = 0; i < 2; i++)
#pragma unroll
        for (int jt = 0; jt < 6; jt++) acc[i][jt] = f32x4{0.f, 0.f, 0.f, 0.f};
#pragma unroll
      for (int i = 0; i < 2; i++) {
        const int R = w * 32 + i * 16;
#pragma unroll
        for (int ks = 0; ks < 4; ks++) {
          if (ks * 32 <= R + 15) {
            const int t = R + lc, s0 = ks * 32 + quad * 8;
            const f32x4 a0 = *(const f32x4*)(wsg + t * 128 + s0), a1 = *(const f32x4*)(wsg + t * 128 + s0 + 4);
            float av[8] = {a0.x, a0.y, a0.z, a0.w, a1.x, a1.y, a1.z, a1.w};
#pragma unroll
            for (int e = 0; e < 8; e++) av[e] = (s0 + e <= t) ? av[e] : 0.f;
            u32x4 au; au.x = pack_bf16(av[0], av[1]); au.y = pack_bf16(av[2], av[3]); au.z = pack_bf16(av[4], av[5]); au.w = pack_bf16(av[6], av[7]);
            const bf16x8 a = as_frag(au);
#pragma unroll
            for (int jt = 0; jt < 6; jt++) {
              const bf16x8 b = *(const bf16x8*)(Vt + ((hh * 6 + jt) * 16 + lc) * 136 + ks * 32 + quad * 8);
              acc[i][jt] = __builtin_amdgcn_mfma_f32_16x16x32_bf16(a, b, acc[i][jt], 0, 0, 0);
            }
          }
        }
      }
#pragma unroll
      for (int i = 0; i < 2; i++) {
        float bs[4];
        u16 zu[4][6];
#pragma unroll
        for (int r = 0; r < 4; r++) {
          const int t = w * 32 + i * 16 + quad * 4 + r;
          bs[r] = bsg[t];
          const u16* zp = p->z + (size_t)(tok0 + t) * ZLD + g * 192 + hh * 96;
#pragma unroll
          for (int jt = 0; jt < 6; jt++) zu[r][jt] = zp[jt * 16 + lc];
        }
#pragma unroll
        for (int r = 0; r < 4; r++) {
          const int t = w * 32 + i * 16 + quad * 4 + r;
          u16* mo = p->mix + (size_t)(tok0 + t) * 1024 + g * 192 + hh * 96;
#pragma unroll
          for (int jt = 0; jt < 6; jt++) mo[jt * 16 + lc] = f2bf(bf2f(zu[r][jt]) * (acc[i][jt][r] + bs[r]));
        }
      }
    }
    __syncthreads();
  }
}

__device__ __forceinline__ void sg_sample_item(PP p, int jl, int b, unsigned char* smem) {
  const int tid = tid_opaque(), lane = tid & 63, w = tid >> 6;
  float* vln = (float*)smem;
  {
    const int tok = T_P + b * 4 + w;
    const u16* zr = p->z + (size_t)tok * ZLD + 768;
    float v[12];
#pragma unroll
    for (int i = 0; i < 3; i++) {
      const u32x2 q = *(const u32x2*)(zr + i * 256 + lane * 4);
      v[i * 4 + 0] = bflo(q.x); v[i * 4 + 1] = bfhi(q.x); v[i * 4 + 2] = bflo(q.y); v[i * 4 + 3] = bfhi(q.y);
    }
    float sum = 0.f;
#pragma unroll
    for (int i = 0; i < 12; i++) sum += v[i];
    const float mu = wave_sum(sum) * (1.0f / 768.0f);
    float sq = 0.f;
#pragma unroll
    for (int i = 0; i < 12; i++) { const float d = v[i] - mu; sq += d * d; }
    const float rs = rsqrtf(wave_sum(sq) * (1.0f / 768.0f) + LN_EPS_F);
    float* og = p->sg_v_sample + ((size_t)(jl * 128 + b) * 4 + w) * 768;
    f32x4 lg[3], lb[3];
#pragma unroll
    for (int i = 0; i < 3; i++) { lg[i] = *(const f32x4*)(p->b_v_ln_g + jl * 768 + i * 256 + lane * 4); lb[i] = *(const f32x4*)(p->b_v_ln_b + jl * 768 + i * 256 + lane * 4); }
#pragma unroll
    for (int i = 0; i < 3; i++) {
      f32x4 o;
      o.x = (v[i * 4 + 0] - mu) * rs * lg[i].x + lb[i].x; o.y = (v[i * 4 + 1] - mu) * rs * lg[i].y + lb[i].y;
      o.z = (v[i * 4 + 2] - mu) * rs * lg[i].z + lb[i].z; o.w = (v[i * 4 + 3] - mu) * rs * lg[i].w + lb[i].w;
      *(f32x4*)(vln + w * 768 + i * 256 + lane * 4) = o;
      *(f32x4*)(og + i * 256 + lane * 4) = o;
    }
  }
  __syncthreads();
  {
    float wv[3][10], bsv[3][4], zu[3][4];
#pragma unroll
    for (int k = 0; k < 3; k++) {
      const int c = tid + k * 256, g = c / 192;
      const float* wsg = p->b_w_s + (size_t)(jl * 4 + g) * 128 * 128;
      const float* bsg = p->b_b_s + (jl * 4 + g) * 128;
      int n = 0;
#pragma unroll
      for (int t = 0; t < 4; t++) {
        bsv[k][t] = bsg[t];
        zu[k][t] = bf2f(p->z[(size_t)(T_P + b * 4 + t) * ZLD + c]);
#pragma unroll
        for (int s2 = 0; s2 <= t; s2++) wv[k][n++] = wsg[t * 128 + s2];
      }
    }
#pragma unroll
    for (int k = 0; k < 3; k++) {
      const int c = tid + k * 256;
      int n = 0;
#pragma unroll
      for (int t = 0; t < 4; t++) {
        float sg = bsv[k][t];
#pragma unroll
        for (int s2 = 0; s2 <= t; s2++) sg += wv[k][n++] * vln[s2 * 768 + c];
        p->mix[(size_t)(T_P + b * 4 + t) * 1024 + c] = f2bf(zu[k][t] * sg);
      }
    }
  }
  __syncthreads();
}

__device__ __forceinline__ void mem_prompt_item(PP p, int layer, int it, unsigned char* smem) {
  const int qoff = (layer & 1) ? 1536 : 1280;
  const int mh = it & 3, tp = it >> 2;
  const int tok0 = tp * 128, b = tok0 >> 13;
  const u16* kb = p->mkvp + ((size_t)(layer * 2 + 0) * 512 + b * 256) * 256 + mh * 64;
  const u16* vb = p->mkvp + ((size_t)(layer * 2 + 1) * 512 + b * 256) * 256 + mh * 64;
  const u16* qb = p->z + (size_t)tok0 * ZLD + qoff + mh * 64;
  u16* ob = p->mix + (size_t)tok0 * 1024 + 768 + mh * 64;
  attn_core<256, false, 2>((u16*)smem, 64,
      [&](int kk, int ch) { return *(const u32x4*)(kb + (size_t)kk * 256 + ch * 8); },
      [&](int kk, int ch) { return *(const u32x4*)(vb + (size_t)kk * 256 + ch * 8); },
      [&](int sub, int row, int ko) { return *(const u32x4*)(qb + (size_t)(sub * 64 + row) * ZLD + ko); },
      [&](int, int, int) { return true; },
      [&](int, int) { return 0.f; },
      [&](int sub, int row) { return ob + (size_t)(sub * 64 + row) * 1024; });
}

__device__ __forceinline__ void mem_sample_item(PP p, int layer, int it, unsigned char* smem) {
  const int qoff = (layer & 1) ? 1536 : 1280;
  const int mh = it & 3, b = it >> 2;
  const float* kb = p->cache_mem_k + ((size_t)(layer * 128 + b) * 256) * 256 + mh * 64;
  const float* vb = p->cache_mem_v + ((size_t)(layer * 128 + b) * 256) * 256 + mh * 64;
  const int tok0 = T_P + b * 4;
  const u16* qb = p->z + (size_t)tok0 * ZLD + qoff + mh * 64;
  u16* ob = p->mix + (size_t)tok0 * 1024 + 768 + mh * 64;
  attn_core<256, false, 1>((u16*)smem, 4,
      [&](int kk, int ch) { return ld_f32x8_as_bf16(kb + (size_t)kk * 256 + ch * 8); },
      [&](int kk, int ch) { return ld_f32x8_as_bf16(vb + (size_t)kk * 256 + ch * 8); },
      [&](int, int row, int ko) { return row < 4 ? *(const u32x4*)(qb + (size_t)row * ZLD + ko) : zero4(); },
      [&](int, int, int) { return true; },
      [&](int, int) { return 0.f; },
      [&](int, int row) { return ob + (size_t)row * 1024; });
}

__device__ __forceinline__ void swa_prompt_item(PP p, int jl, int it, unsigned char* smem) {
  const int kvh = it & 3, hb = it >> 2;
  const int tok0 = hb * 64, b = tok0 >> 13, q0 = tok0 & 8191;
  const u16* zb = p->z + (size_t)(b * 8192) * ZLD;
  const u16* qb = p->z + (size_t)tok0 * ZLD + kvh * 192;
  u16* ob = p->mix + (size_t)tok0 * 1024 + kvh * 192;
  const float sk0 = p->a_sink[jl * 12 + kvh * 3], sk1 = p->a_sink[jl * 12 + kvh * 3 + 1], sk2 = p->a_sink[jl * 12 + kvh * 3 + 2];
  attn_core<192, true, 3>((u16*)smem, 64,
      [&](int kk, int ch) { const int kp = q0 - 128 + kk; return kp >= 0 ? *(const u32x4*)(zb + (size_t)kp * ZLD + 768 + kvh * 64 + ch * 8) : zero4(); },
      [&](int kk, int ch) { const int kp = q0 - 128 + kk; return kp >= 0 ? *(const u32x4*)(zb + (size_t)kp * ZLD + 1024 + kvh * 64 + ch * 8) : zero4(); },
      [&](int sub, int row, int ko) { return *(const u32x4*)(qb + (size_t)row * ZLD + sub * 64 + ko); },
      [&](int, int row, int kk) { const int qp = q0 + row, kp = q0 - 128 + kk; return kp >= 0 && kp <= qp && qp - kp < 128; },
      [&](int sub, int) { return sub == 0 ? sk0 : (sub == 1 ? sk1 : sk2); },
      [&](int sub, int row) { return ob + (size_t)row * 1024 + sub * 64; });
}

__device__ __forceinline__ void swa_sample_item(PP p, int jl, int it, unsigned char* smem) {
  const int kvh = it & 3, b = it >> 2;
  const float* ck = p->cache_swa_k + ((size_t)(jl * 128 + b) * 128) * 256 + kvh * 64;
  const float* cv = p->cache_swa_v + ((size_t)(jl * 128 + b) * 128) * 256 + kvh * 64;
  const int tok0 = T_P + b * 4;
  const u16* zb = p->z + (size_t)tok0 * ZLD;
  u16* ob = p->mix + (size_t)tok0 * 1024;
  const float* sk = p->a_sink + jl * 12 + kvh * 3;
  attn_core<160, true, 1>((u16*)smem, 12,
      [&](int kk, int ch) {
        if (kk < 128) return ld_f32x8_as_bf16(ck + (size_t)kk * 256 + ch * 8);
        if (kk < 132) return *(const u32x4*)(zb + (size_t)(kk - 128) * ZLD + 768 + kvh * 64 + ch * 8);
        return zero4(); },
      [&](int kk, int ch) {
        if (kk < 128) return ld_f32x8_as_bf16(cv + (size_t)kk * 256 + ch * 8);
        if (kk < 132) return *(const u32x4*)(zb + (size_t)(kk - 128) * ZLD + 1024 + kvh * 64 + ch * 8);
        return zero4(); },
      [&](int, int row, int ko) { return row < 12 ? *(const u32x4*)(zb + (size_t)(row / 3) * ZLD + (kvh * 3 + row % 3) * 64 + ko) : zero4(); },
      [&](int, int row, int kk) { const int t = row / 3; return kk < 128 ? (kk > t) : (kk < 132 && (kk - 128) <= t); },
      [&](int, int row) { return row < 12 ? sk[row % 3] : 0.f; },
      [&](int, int row) { return ob + (size_t)(row / 3) * 1024 + (kvh * 3 + row % 3) * 64; });
}

__device__ __forceinline__ void phase_mixer(PP p, int layer, unsigned char* smem) {
  const int jl = layer >> 1;
  if (!(layer & 1)) {
    for (int it = bid_opaque(); it < 2560; it += gridDim.x) {
      if (it < 1024) swa_prompt_item(p, jl, it, smem);
      else if (it < 1536) mem_prompt_item(p, layer, it - 1024, smem);
      else if (it < 2048) swa_sample_item(p, jl, it - 1536, smem);
      else mem_sample_item(p, layer, it - 2048, smem);
    }
  } else {
    for (int it = bid_opaque(); it < 1664; it += gridDim.x) {
      if (it < 512) sg_prompt_item(p, jl, it, smem);
      else if (it < 1024) mem_prompt_item(p, layer, it - 512, smem);
      else if (it < 1152) sg_sample_item(p, jl, it - 1024, smem);
      else mem_sample_item(p, layer, it - 1152, smem);
    }
  }
}

__device__ __forceinline__ void phase_outproj(PP p, int layer, unsigned char* smem) {
  const int tid = tid_opaque(), lane = tid & 63, w = tid >> 6, wm = w >> 1, wn = w & 1, quad = lane >> 4, lc = lane & 15;
  const u16* W = p->wT_out + (size_t)layer * 1024 * 1024;
  for (int t = bid_opaque(); t < 132 * 8; t += gridDim.x) {
    const int tx = xcd_tile(t, 132 * 8);
    const int tm = tx >> 3, tn = tx & 7;
    f32x4 acc[4][4];
    gemm128(p->mix + (size_t)tm * 128 * 1024, 1024, W + (size_t)tn * 128 * 1024, 1024, 1024, (u16*)smem, acc);
    float* Cs = (float*)smem;
#pragma unroll
    for (int i = 0; i < 4; i++)
#pragma unroll
      for (int j = 0; j < 4; j++)
#pragma unroll
        for (int r = 0; r < 4; r++) Cs[(wm * 64 + i * 16 + quad * 4 + r) * 132 + wn * 64 + j * 16 + lc] = acc[i][j][r];
    __syncthreads();
    const size_t gbase = (size_t)(tm * 128) * 1024 + tn * 128 + (tid & 31) * 4;
#pragma unroll
    for (int hb = 0; hb < 2; hb++) {
      f32x4 res[8];
#pragma unroll
      for (int it = 0; it < 8; it++) res[it] = *(const f32x4*)(p->xf + gbase + (size_t)((hb * 8 + it) * 8 + (tid >> 5)) * 1024);
#pragma unroll
      for (int it = 0; it < 8; it++) {
        const int row = (hb * 8 + it) * 8 + (tid >> 5);
        const f32x4 c = *(const f32x4*)(Cs + row * 132 + (tid & 31) * 4);
        *(f32x4*)(p->pre + gbase + (size_t)row * 1024) = DN_ALPHA_F * res[it] + c;
      }
    }
    __syncthreads();
  }
  convert_tables_part(p, layer, 1);
}

__device__ __forceinline__ void phase_ln1(PP p, int layer) {
  const int tid = tid_opaque(), lane = tid & 63, w = tid >> 6;
  const float* g = p->ln1_g + layer * 1024;
  const float* bb = p->ln1_b + layer * 1024;
  for (int tok = bid_opaque() * 4 + w; tok < T_ALL; tok += gridDim.x * 4) {
    float v[16];
#pragma unroll
    for (int i = 0; i < 4; i++) {
      const f32x4 q = *(const f32x4*)(p->pre + (size_t)tok * 1024 + i * 256 + lane * 4);
      v[i * 4] = q.x; v[i * 4 + 1] = q.y; v[i * 4 + 2] = q.z; v[i * 4 + 3] = q.w;
    }
    float sum = 0.f;
#pragma unroll
    for (int i = 0; i < 16; i++) sum += v[i];
    const float mu = wave_sum(sum) * (1.0f / 1024.0f);
    float sq = 0.f;
#pragma unroll
    for (int i = 0; i < 16; i++) { const float d = v[i] - mu; sq += d * d; }
    const float rs = rsqrtf(wave_sum(sq) * (1.0f / 1024.0f) + LN_EPS_F);
    f32x4 gg[4], bv[4];
#pragma unroll
    for (int i = 0; i < 4; i++) { gg[i] = *(const f32x4*)(g + i * 256 + lane * 4); bv[i] = *(const f32x4*)(bb + i * 256 + lane * 4); }
#pragma unroll
    for (int i = 0; i < 4; i++) {
      const int c = i * 256 + lane * 4;
      f32x4 o;
      o.x = (v[i * 4] - mu) * rs * gg[i].x + bv[i].x; o.y = (v[i * 4 + 1] - mu) * rs * gg[i].y + bv[i].y;
      o.z = (v[i * 4 + 2] - mu) * rs * gg[i].z + bv[i].z; o.w = (v[i * 4 + 3] - mu) * rs * gg[i].w + bv[i].w;
      *(f32x4*)(p->xf + (size_t)tok * 1024 + c) = o;
      *(u32x2*)(p->xb + (size_t)tok * 1024 + c) = u32x2{pack_bf16(o.x, o.y), pack_bf16(o.z, o.w)};
    }
  }
}

__device__ __forceinline__ void phase_peerq(PP p, int layer, unsigned char* smem) {
  const int tid = tid_opaque(), lane = tid & 63, w = tid >> 6, wm = w >> 1, wn = w & 1, quad = lane >> 4, lc = lane & 15;
  const u16* W = p->wT_pq + (size_t)layer * 2048 * 1024;
  const float* bq = p->peer_b_q + layer * 2048;
  u16* Qs = (u16*)smem;
  uint32_t* Sk = (uint32_t*)smem;
  for (int t = bid_opaque(); t < 132 * 16; t += gridDim.x) {
    const int tx = xcd_tile(t, 132 * 16);
    const int tm = tx >> 4, tn = tx & 15;
    f32x4 acc[4][4];
    gemm128(p->xb + (size_t)tm * 128 * 1024, 1024, W + (size_t)tn * 128 * 1024, 1024, 1024, (u16*)smem, acc);
#pragma unroll
    for (int i = 0; i < 4; i++)
#pragma unroll
      for (int j = 0; j < 4; j++) {
        const int col = wn * 64 + j * 16 + lc;
        const float bias = bq[tn * 128 + col];
#pragma unroll
        for (int r = 0; r < 4; r++) Qs[(wm * 64 + i * 16 + quad * 4 + r) * 136 + col] = f2bf(acc[i][j][r] + bias);
      }
    __syncthreads();
    const u16* sk = p->subk + ((size_t)layer * 16 + tn) * 128 * 128;
#pragma unroll
    for (int i = 0; i < 4; i++)
#pragma unroll
      for (int j = 0; j < 4; j++) acc[i][j] = f32x4{0.f, 0.f, 0.f, 0.f};
#pragma unroll
    for (int ks = 0; ks < 4; ks++) {
      bf16x8 af[4], bfr[4];
#pragma unroll
      for (int i = 0; i < 4; i++) af[i] = *(const bf16x8*)(Qs + (wm * 64 + i * 16 + lc) * 136 + ks * 32 + quad * 8);
#pragma unroll
      for (int j = 0; j < 4; j++) bfr[j] = *(const bf16x8*)(sk + (size_t)(wn * 64 + j * 16 + lc) * 128 + ks * 32 + quad * 8);
#pragma unroll
      for (int i = 0; i < 4; i++)
#pragma unroll
        for (int j = 0; j < 4; j++) acc[i][j] = __builtin_amdgcn_mfma_f32_16x16x32_bf16(af[i], bfr[j], acc[i][j], 0, 0, 0);
    }
    __syncthreads();
#pragma unroll
    for (int i = 0; i < 4; i++)
#pragma unroll
      for (int j = 0; j < 4; j++) {
        const int n = wn * 64 + j * 16 + lc;
#pragma unroll
        for (int r = 0; r < 4; r++) {
          const uint32_t u = __float_as_uint(acc[i][j][r]);
          const uint32_t m = (u & 0x80000000u) ? ~u : (u | 0x80000000u);
          Sk[(wm * 64 + i * 16 + quad * 4 + r) * 129 + n] = (m & ~127u) | (uint32_t)(127 - n);
        }
      }
    __syncthreads();
    if (tid < 128) {
      uint32_t k[128];
#pragma unroll
      for (int e = 0; e < 128; e++) k[e] = Sk[tid * 129 + e];
#pragma unroll
      for (int size = 2; size <= 16; size <<= 1) {
#pragma unroll
        for (int stride = size >> 1; stride > 0; stride >>= 1) {
#pragma unroll
          for (int i = 0; i < 128; i++) {
            const int j = i ^ stride;
            if (j > i) {
              const uint32_t mx = k[i] > k[j] ? k[i] : k[j], mn = k[i] > k[j] ? k[j] : k[i];
              if ((i & size) == 0) { k[i] = mx; k[j] = mn; } else { k[i] = mn; k[j] = mx; }
            }
          }
        }
      }
#pragma unroll
      for (int ng = 4; ng >= 1; ng >>= 1) {
#pragma unroll
        for (int m = 0; m < ng; m++) {
#pragma unroll
          for (int i = 0; i < 16; i++) {
            const uint32_t a = k[(2 * m) * 16 + i], b = k[(2 * m + 1) * 16 + i];
            k[m * 16 + i] = a > b ? a : b;
          }
        }
#pragma unroll
        for (int stride = 8; stride > 0; stride >>= 1) {
#pragma unroll
          for (int i = 0; i < 16 * ng; i++) {
            const int j = i ^ stride;
            if (j > i) {
              const uint32_t mx = k[i] > k[j] ? k[i] : k[j], mn = k[i] > k[j] ? k[j] : k[i];
              if ((i & 16) == 0) { k[i] = mx; k[j] = mn; } else { k[i] = mn; k[j] = mx; }
            }
          }
        }
      }
      u32x4* o = (u32x4*)(p->topk + ((size_t)(tm * 128 + tid) * 16 + tn) * 16);
#pragma unroll
      for (int q = 0; q < 4; q++) {
        u32x4 v;
#pragma unroll
        for (int e = 0; e < 4; e++) { const uint32_t b = k[q * 4 + e]; v[e] = (b & ~127u) | (127u - (b & 127u)); }
        o[q] = v;
      }
    }
    __syncthreads();
  }
  convert_tables_part(p, layer, 2);
}

__device__ __forceinline__ float dec_key(uint32_t key) {
  const uint32_t m = key & ~127u;
  return __uint_as_float((m & 0x80000000u) ? (m ^ 0x80000000u) : ~m);
}

__device__ __forceinline__ void phase_gather(PP p, int layer) {
  const int tid = tid_opaque(), lane = tid & 63, w = tid >> 6;
  const int hl = lane & 31;
  const bool hi_half = lane >= 32;
  const unsigned char* ubl = p->ub + (size_t)layer * 16384 * 1280 + hl * 24;
  const unsigned char* vbl = p->ub + (size_t)layer * 16384 * 1280 + 768 + hl * 16;
  const float* g2 = p->ln2_g + layer * 1024;
  const float* b2 = p->ln2_b + layer * 1024;
  const int ci = c_cand[lane] >> 4, cj = c_cand[lane] & 15;
  float* xo = (layer == 3) ? p->y_out : p->xf;
  for (int tok = bid_opaque() * 4 + w; tok < T_ALL; tok += gridDim.x * 4) {
    f32x32 x, y;
    {
      const float* xr = p->xf + (size_t)tok * 1024 + hl * 32;
#pragma unroll
      for (int i = 0; i < 8; i++) {
        const f32x4 a = *(const f32x4*)(xr + i * 4);
        x[i * 4] = a.x; x[i * 4 + 1] = a.y; x[i * 4 + 2] = a.z; x[i * 4 + 3] = a.w;
      }
    }
#pragma unroll
    for (int i = 0; i < 32; i++) y[i] = 0.f;
    uint32_t k0n = p->topk[(size_t)tok * 256 + ci], k1n = p->topk[(size_t)tok * 256 + 16 + cj];
    for (int h = 0; h < 8; h++) {
      const uint32_t k0 = k0n, k1 = k1n;
      if (h + 1 < 8) { const uint32_t* tk = p->topk + ((size_t)tok * 16 + (h + 1) * 2) * 16; k0n = tk[ci]; k1n = tk[16 + cj]; }
      float cand = dec_key(k0) + dec_key(k1);
      int eid = (int)((k0 & 127u) * 128u + (k1 & 127u));
      uint32_t ckey;
      {
        const uint32_t u = __float_as_uint(cand);
        const uint32_t m = (u & 0x80000000u) ? ~u : (u | 0x80000000u);
        ckey = (lane < 50) ? ((m & ~63u) | (uint32_t)(63 - lane)) : 0u;
      }
      int rank = 0;
#pragma unroll
      for (int l2 = 0; l2 < 50; l2++) {
        const uint32_t o = (uint32_t)__builtin_amdgcn_readlane((int)ckey, l2);
        rank += (o > ckey) ? 1 : 0;
      }
      const int dst = (rank < 16) ? ((rank & 1) * 32 + (rank >> 1) * 4) : 1;
      const float fsel = __int_as_float(__builtin_amdgcn_ds_permute(dst * 4, __float_as_int(cand)));
      const int esel = __builtin_amdgcn_ds_permute(dst * 4, eid);
      const float f0 = __int_as_float(__builtin_amdgcn_readlane(__float_as_int(fsel), 0));
      float ev = ((lane & 3) == 0) ? __expf(fsel - f0) : 0.f;
      float es = ev;
      es += __shfl_xor(es, 4); es += __shfl_xor(es, 8); es += __shfl_xor(es, 16); es += __shfl_xor(es, 32);
      const float gate = ev / es;
      int e[16];
#pragma unroll
      for (int k = 0; k < 16; k++) e[k] = __builtin_amdgcn_readlane(esel, (k & 1) * 32 + (k >> 1) * 4);
      float pd[8];
      u32x4 wv[8];
      {
        u32x2 wu[8][3];
#pragma unroll
        for (int m = 0; m < 8; m++) {
          const u32x2* rp = (const u32x2*)(ubl + (size_t)(hi_half ? e[2 * m + 1] : e[2 * m]) * 1280);
          wu[m][0] = rp[0]; wu[m][1] = rp[1]; wu[m][2] = rp[2];
        }
#pragma unroll
        for (int m = 0; m < 8; m++) wv[m] = *(const u32x4*)(vbl + (size_t)(hi_half ? e[2 * m + 1] : e[2 * m]) * 1280);
        __builtin_amdgcn_sched_barrier(0);
#pragma unroll
        for (int m = 0; m < 8; m++) {
          const u32x6 pk = {wu[m][0].x, wu[m][0].y, wu[m][1].x, wu[m][1].y, wu[m][2].x, wu[m][2].y};
          const f32x32 f = __builtin_amdgcn_cvt_scalef32_pk32_f32_fp6(pk, 1.0f);
          f32x2 a0 = {0.f, 0.f}, a1 = {0.f, 0.f};
#pragma unroll
          for (int i = 0; i < 8; i++) {
            a0 += f32x2{f[4 * i], f[4 * i + 1]} * f32x2{x[4 * i], x[4 * i + 1]};
            a1 += f32x2{f[4 * i + 2], f[4 * i + 3]} * f32x2{x[4 * i + 2], x[4 * i + 3]};
          }
          pd[m] = (a0.x + a0.y) + (a1.x + a1.y);
          __builtin_amdgcn_sched_barrier(0);
        }
      }
      float q4[4], q2[2], q1;
      {
        const bool hi = lane & 16;
#pragma unroll
        for (int k = 0; k < 4; k++) { const float give = hi ? pd[k] : pd[k + 4]; const float keep = hi ? pd[k + 4] : pd[k]; q4[k] = keep + __shfl_xor(give, 16); }
      }
      {
        const bool hi = lane & 8;
#pragma unroll
        for (int k = 0; k < 2; k++) { const float give = hi ? q4[k] : q4[k + 2]; const float keep = hi ? q4[k + 2] : q4[k]; q2[k] = keep + __shfl_xor(give, 8); }
      }
      {
        const bool hi = lane & 4;
        const float give = hi ? q2[0] : q2[1]; const float keep = hi ? q2[1] : q2[0];
        q1 = keep + __shfl_xor(give, 4);
      }
      q1 += __shfl_xor(q1, 2);
      q1 += __shfl_xor(q1, 1);
      __builtin_amdgcn_sched_barrier(0);
      {
        const float aval = gate * gelu_exact(q1 * (1.0f / PEER_SU)) * (1.0f / PEER_SV);
        __builtin_amdgcn_sched_barrier(0);
#pragma unroll
        for (int m = 0; m < 8; m++) {
          const float alo = __int_as_float(__builtin_amdgcn_readlane(__float_as_int(aval), 4 * m));
          const float ahi = __int_as_float(__builtin_amdgcn_readlane(__float_as_int(aval), 32 + 4 * m));
          const float a = hi_half ? ahi : alo;
          const f32x2 a2 = {a, a};
#define FP4_ACC(WD, BS) { const f32x2 f = __builtin_amdgcn_cvt_scalef32_pk_f32_fp4(wv[m][WD], 1.0f, BS); \
            const f32x2 r = f32x2{y[2 * (WD * 4 + BS)], y[2 * (WD * 4 + BS) + 1]} + a2 * f; y[2 * (WD * 4 + BS)] = r.x; y[2 * (WD * 4 + BS) + 1] = r.y; }
#define FP4_ACC4(WD) FP4_ACC(WD, 0) FP4_ACC(WD, 1) FP4_ACC(WD, 2) FP4_ACC(WD, 3)
          FP4_ACC4(0) FP4_ACC4(1) FP4_ACC4(2) FP4_ACC4(3)
          __builtin_amdgcn_sched_barrier(0);
        }
      }
    }
    float sum = 0.f;
#pragma unroll
    for (int i = 0; i < 32; i++) { y[i] += __shfl_xor(y[i], 32); y[i] = fmaf(DN_ALPHA_F, x[i], y[i]); sum += y[i]; }
    sum += __shfl_xor(sum, 16); sum += __shfl_xor(sum, 8); sum += __shfl_xor(sum, 4); sum += __shfl_xor(sum, 2); sum += __shfl_xor(sum, 1);
    const float mu = sum * (1.0f / 1024.0f);
    float sq = 0.f;
#pragma unroll
    for (int i = 0; i < 32; i++) { const float d = y[i] - mu; sq += d * d; }
    sq += __shfl_xor(sq, 16); sq += __shfl_xor(sq, 8); sq += __shfl_xor(sq, 4); sq += __shfl_xor(sq, 2); sq += __shfl_xor(sq, 1);
    const float rs = rsqrtf(sq * (1.0f / 1024.0f) + LN_EPS_F);
    f32x4 ga[8], ba[8];
#pragma unroll
    for (int i = 0; i < 8; i++) { ga[i] = *(const f32x4*)(g2 + hl * 32 + i * 4); ba[i] = *(const f32x4*)(b2 + hl * 32 + i * 4); }
    f32x4 o[8];
#pragma unroll
    for (int i = 0; i < 8; i++) {
      o[i].x = (y[i * 4 + 0] - mu) * rs * ga[i].x + ba[i].x; o[i].y = (y[i * 4 + 1] - mu) * rs * ga[i].y + ba[i].y;
      o[i].z = (y[i * 4 + 2] - mu) * rs * ga[i].z + ba[i].z; o[i].w = (y[i * 4 + 3] - mu) * rs * ga[i].w + ba[i].w;
    }
    if (!hi_half) {
#pragma unroll
      for (int i = 0; i < 8; i++) *(f32x4*)(xo + (size_t)tok * 1024 + hl * 32 + i * 4) = o[i];
    } else {
#pragma unroll
      for (int i = 0; i < 4; i++) *(u32x4*)(p->xb + (size_t)tok * 1024 + hl * 32 + i * 8) = cvt8(o[2 * i], o[2 * i + 1]);
    }
  }
}

#define XB_TMO      128
#define XB_XCNT(j)  (256  + 64 * (j))
#define XB_XSUB(j)  (1280 + 64 * (j))
#define XB_XGEN(j)  (2304 + 64 * (j))
#define XB_TOP      3328
#define XB_TOPGEN   3392
#define XCD_BAR_WORDS 3456
#define XB_SPIN_CAP (1u << 18)
#define LAS __attribute__((address_space(3)))
__device__ __forceinline__ unsigned xb_ld(unsigned* p)              { return __hip_atomic_load(p, __ATOMIC_RELAXED, __HIP_MEMORY_SCOPE_AGENT); }
__device__ __forceinline__ unsigned xb_add(unsigned* p, unsigned v) { return __hip_atomic_fetch_add(p, v, __ATOMIC_RELAXED, __HIP_MEMORY_SCOPE_AGENT); }
__device__ __forceinline__ unsigned xb_xcc_id() { return (unsigned)__builtin_amdgcn_s_getreg((3 << 11) | 20) & 0xFu; }
#define XB_SPIN(cond, bar) do { unsigned _sp = 0; while (cond) { __builtin_amdgcn_s_sleep(1); \
    if ((++_sp & 255u) == 0u) { if (xb_ld(&(bar)[XB_TMO])) break; if (_sp > XB_SPIN_CAP) { atomicAdd(&(bar)[XB_TMO], 1u); break; } } } } while (0)
struct XcdBarrier { unsigned* bar; unsigned x; volatile LAS unsigned* st; };
__device__ __forceinline__ XcdBarrier xcd_barrier_post(unsigned* bar, volatile LAS unsigned* st) {
  XcdBarrier b; b.bar = bar; b.x = xb_xcc_id(); b.st = st;
  if (threadIdx.x == 0) (void)xb_add(&bar[XB_XCNT(b.x)], 1u);
  return b;
}
__device__ __forceinline__ void xcd_barrier_complete(unsigned* bar, unsigned x, unsigned& nloc, unsigned& nx) {
  const unsigned G = gridDim.x * gridDim.y * gridDim.z;
  unsigned sum, cnt, mine, sp = 0u;
  for (;;) {
    sum = 0u; cnt = 0u; mine = 0u;
#pragma unroll
    for (unsigned j = 0; j < 16; ++j) { const unsigned c = xb_ld(&bar[XB_XCNT(j)]); sum += c; cnt += (c > 0u) ? 1u : 0u; mine = (j == x) ? c : mine; }
    if (sum == G) break;
    __builtin_amdgcn_s_sleep(1);
    if ((++sp & 255u) == 0u) { if (xb_ld(&bar[XB_TMO])) break; if (sp > XB_SPIN_CAP) { atomicAdd(&bar[XB_TMO], 1u); break; } }
  }
  nloc = mine > 0u ? mine : 1u; nx = cnt > 0u ? cnt : 1u;
}
__device__ __forceinline__ void xcd_barrier(const XcdBarrier& b) {
  asm volatile("s_waitcnt vmcnt(0)" ::: "memory");
  __syncthreads();
  if (threadIdx.x == 0) {
    unsigned* bar = b.bar;
    __builtin_amdgcn_s_waitcnt(0);
    unsigned nloc = b.st[0], nx = b.st[1];
    if (nloc == 0u) { xcd_barrier_complete(bar, b.x, nloc, nx); b.st[0] = nloc; b.st[1] = nx; }
    const unsigned old = xb_add(&bar[XB_XSUB(b.x)], 1u);
    const unsigned gen = old / nloc;
    if (old + 1u == (gen + 1u) * nloc) {
      __builtin_amdgcn_fence(__ATOMIC_RELEASE, "agent");
      asm volatile("s_waitcnt vmcnt(0)" ::: "memory");
      const unsigned og = xb_add(&bar[XB_TOP], 1u);
      const unsigned tg = og / nx;
      if (og + 1u == (tg + 1u) * nx) xb_add(&bar[XB_TOPGEN], 1u);
      else XB_SPIN(xb_ld(&bar[XB_TOPGEN]) == tg, bar);
      __builtin_amdgcn_fence(__ATOMIC_ACQUIRE, "agent");
      xb_add(&bar[XB_XGEN(b.x)], 1u);
      asm volatile("s_waitcnt vmcnt(0)" ::: "memory");
    } else {
      XB_SPIN(xb_ld(&bar[XB_XGEN(b.x)]) == gen, bar);
      __builtin_amdgcn_fence(__ATOMIC_ACQUIRE, "agent");
      asm volatile("s_waitcnt vmcnt(0)" ::: "memory");
    }
  }
  __syncthreads();
}

__global__ void __launch_bounds__(256, 2) mega(Params p_arg, int ph_lo, int ph_hi, int coop) {
  __shared__ __attribute__((aligned(16))) unsigned char smem[SMEM_BYTES];
  __shared__ u32x4 xb_words;
  cg::grid_group grid = cg::this_grid();
  if (threadIdx.x == 0) xb_words = u32x4{0u, 0u, 0u, 0u};
  __syncthreads();
  if (coop) (void)xcd_barrier_post(((PP)__builtin_amdgcn_kernarg_segment_ptr())->bar, (volatile LAS unsigned*)&xb_words);
  for (int ph = ph_lo; ph < ph_hi; ph++) {
    const int reps = (int)((PROBE_MASK >> ph) & 1u) + 1;
    for (int rep = 0; rep < reps; rep++) {
      PP p = (PP)__builtin_amdgcn_kernarg_segment_ptr();
      asm volatile("" : "+s"(p));
      if (ph == 0) {
        phase_prologue(p, smem);
      } else {
        const int layer = (ph - 1) / 6, k = (ph - 1) % 6;
        switch (k) {
          case 0: phase_inproj(p, layer, smem); break;
          case 1: phase_mixer(p, layer, smem); break;
          case 2: phase_outproj(p, layer, smem); break;
          case 3: phase_ln1(p, layer); break;
          case 4: phase_peerq(p, layer, smem); break;
          default: phase_gather(p, layer); break;
        }
      }
      if (coop == 1 && (rep + 1 < reps || ph + 1 < ph_hi)) {
        XcdBarrier xb; xb.bar = p->bar; xb.x = xb_xcc_id(); xb.st = (volatile LAS unsigned*)&xb_words;
        xcd_barrier(xb);
      }
      if (coop == 2) grid.sync();
    }
  }
}

extern "C" void kernel_launch(void* const* d_in, const int* in_sizes, int n_in, void* d_out, int out_size, void* d_ws,
                              size_t ws_size, hipStream_t stream) {
  Params p{};
  p.x_prompt = (const float*)d_in[0]; p.x_sample = (const float*)d_in[1];
  p.cache_swa_k = (const float*)d_in[2]; p.cache_swa_v = (const float*)d_in[3];
  p.cache_mem_k = (const float*)d_in[4]; p.cache_mem_v = (const float*)d_in[5];
  p.mem_prompt = (const float*)d_in[6];
  p.a_w_in = (const float*)d_in[7]; p.a_sink = (const float*)d_in[8]; p.b_w_in = (const float*)d_in[9];
  p.b_v_ln_g = (const float*)d_in[10]; p.b_v_ln_b = (const float*)d_in[11]; p.b_w_s = (const float*)d_in[12];
  p.b_b_s = (const float*)d_in[13]; p.w_mem_kv = (const float*)d_in[14]; p.w_out = (const float*)d_in[15];
  p.ln1_g = (const float*)d_in[16]; p.ln1_b = (const float*)d_in[17]; p.ln2_g = (const float*)d_in[18]; p.ln2_b = (const float*)d_in[19];
  p.peer_w_q = (const float*)d_in[20]; p.peer_b_q = (const float*)d_in[21]; p.peer_subkeys = (const float*)d_in[22];
  p.peer_u = (const float*)d_in[23]; p.peer_v = (const float*)d_in[24];
  float* o = (float*)d_out;
  p.y_out = o;                       o += (size_t)T_ALL * 1024;
  p.swa_k_prompt = o;                o += 131072;
  p.swa_v_prompt = o;                o += 131072;
  p.swa_k_sample = o;                o += 262144;
  p.swa_v_sample = o;                o += 262144;
  p.sg_v_sample = o;                 o += 786432;
  p.mem_k_prompt = o;                o += 524288;
  p.mem_v_prompt = o;
  unsigned char* wsb = (unsigned char*)d_ws;
  size_t off = 0;
  auto carve = [&](size_t bytes) { void* r = wsb + off; off += (bytes + 255) & ~(size_t)255; return r; };
  p.wT_a_in = (u16*)carve((size_t)2 * 1536 * 1024 * 2);
  p.wT_b_in = (u16*)carve((size_t)2 * 1792 * 1024 * 2);
  p.wT_memkv = (u16*)carve((size_t)4 * 512 * 1024 * 2);
  p.wT_out = (u16*)carve((size_t)4 * 1024 * 1024 * 2);
  p.wT_pq = (u16*)carve((size_t)4 * 2048 * 1024 * 2);
  p.subk = (u16*)carve((size_t)4 * 8 * 2 * 128 * 128 * 2);
  p.ub = (unsigned char*)carve((size_t)4 * 16384 * 1280);
  p.vb = p.ub;
  p.memb = (u16*)carve((size_t)512 * 1024 * 2);
  p.xb = (u16*)carve((size_t)T_ALL * 1024 * 2);
  p.z = (u16*)carve((size_t)T_ALL * ZLD * 2);
  p.mix = (u16*)carve((size_t)T_ALL * 1024 * 2);
  p.mkvp = (u16*)carve((size_t)4 * 2 * 512 * 256 * 2);
  p.xf = (float*)carve((size_t)T_ALL * 1024 * 4);
  p.pre = (float*)carve((size_t)T_ALL * 1024 * 4);
  p.ropecs = (float*)carve((size_t)8196 * 8 * 2 * 4);
  p.topk = (uint32_t*)carve((size_t)T_ALL * 16 * 16 * 4);
  p.bar = (unsigned*)carve((size_t)XCD_BAR_WORDS * 4);
  if (off > ws_size) { fprintf(stderr, "workspace too small: need %zu have %zu\n", off, ws_size); return; }

  static int grid_blocks = 0;
  if (!grid_blocks) {
    int dev = 0, cus = 0, per_cu = 0;
    (void)hipGetDevice(&dev);
    (void)hipDeviceGetAttribute(&cus, hipDeviceAttributeMultiprocessorCount, dev);
    (void)hipOccupancyMaxActiveBlocksPerMultiprocessor(&per_cu, mega, 256, 0);
    if (per_cu < 1) per_cu = 1;
    if (per_cu > 2) per_cu = 2;
    grid_blocks = cus * per_cu;
  }
#if MK_MULTI
  for (int ph = 0; ph < N_PHASES; ph++) mega<<<dim3(grid_blocks), dim3(256), 0, stream>>>(p, ph, ph + 1, 0);
#else
  (void)hipMemsetAsync(p.bar, 0, (size_t)XCD_BAR_WORDS * 4, stream);
  int lo = 0, hi = N_PHASES, coop = 1;
  void* args[] = {&p, &lo, &hi, &coop};
  hipError_t e = hipLaunchCooperativeKernel((void*)mega, dim3(grid_blocks), dim3(256), args, 0, stream);
  if (e != hipSuccess) fprintf(stderr, "cooperative launch failed: %s (grid %d)\n", hipGetErrorString(e), grid_blocks);
#endif
}
```

```cpp
#include <hip/hip_runtime.h>
#include <hip/hip_cooperative_groups.h>
#include <stdint.h>
#include <cstdio>
namespace cg = cooperative_groups;

#ifndef MK_MULTI
#define MK_MULTI 0
#endif

typedef unsigned short u16;
typedef __attribute__((ext_vector_type(8))) short bf16x8;
typedef __attribute__((ext_vector_type(4))) float f32x4;
typedef __attribute__((ext_vector_type(2))) float f32x2;
typedef __attribute__((ext_vector_type(4))) unsigned int u32x4;
typedef __attribute__((ext_vector_type(2))) unsigned int u32x2;
typedef __attribute__((ext_vector_type(6))) unsigned int u32x6;
typedef __attribute__((ext_vector_type(16))) float f32x16;
typedef __attribute__((ext_vector_type(32))) float f32x32;

#define T_P 16384
#define T_ALL 16896
#define ZLD 1792
#define SMEM_BYTES 73728
#define DN_ALPHA_F 1.6817928305074292f
#define LN_EPS_F 1e-5f
#define N_PHASES 25
#define PEER_SU 48.0f
#define PEER_SV 12.0f
#ifndef PROBE_MASK
#define PROBE_MASK 0u
#endif

struct Params {
  const float *x_prompt, *x_sample, *cache_swa_k, *cache_swa_v, *cache_mem_k, *cache_mem_v, *mem_prompt;
  const float *a_w_in, *a_sink, *b_w_in, *b_v_ln_g, *b_v_ln_b, *b_w_s, *b_b_s, *w_mem_kv, *w_out;
  const float *ln1_g, *ln1_b, *ln2_g, *ln2_b, *peer_w_q, *peer_b_q, *peer_subkeys, *peer_u, *peer_v;
  float *y_out, *swa_k_prompt, *swa_v_prompt, *swa_k_sample, *swa_v_sample, *sg_v_sample, *mem_k_prompt, *mem_v_prompt;
  u16 *wT_a_in, *wT_b_in, *wT_memkv, *wT_out, *wT_pq, *subk, *memb, *xb, *z, *mix, *mkvp;
  unsigned char *ub, *vb;
  float *xf, *pre, *ropecs;
  uint32_t *topk;
  unsigned *bar;
};

typedef const __attribute__((address_space(4))) Params* PP;

__constant__ double c_rope_inv[8] = {1.0, 0.19392274474868576, 0.03760603093086393, 0.007292664737217109,
  0.001414213562373095, 0.0002742481756762073, 5.318295896944988e-05, 1.031338537721246e-05};
__constant__ unsigned char c_cand[64] = {
  0x00,0x01,0x02,0x03,0x04,0x05,0x06,0x07,0x08,0x09,0x0a,0x0b,0x0c,0x0d,0x0e,0x0f,0x10,0x11,0x12,0x13,0x14,0x15,0x16,0x17,
  0x20,0x21,0x22,0x23,0x24,0x30,0x31,0x32,0x33,0x40,0x41,0x42,0x50,0x51,0x60,0x61,0x70,0x71,0x80,0x90,0xa0,0xb0,0xc0,0xd0,
  0xe0,0xf0,0,0,0,0,0,0,0,0,0,0,0,0,0,0};

__device__ __forceinline__ int tid_opaque() { int t = threadIdx.x; asm volatile("" : "+v"(t)); return t; }
__device__ __forceinline__ int bid_opaque() { int b = blockIdx.x; asm volatile("" : "+s"(b)); return b; }
__device__ __forceinline__ u32x4 zero4() { uint32_t z = 0; asm volatile("" : "+v"(z)); return u32x4{z, z, z, z}; }
__device__ __forceinline__ uint32_t pack_bf16(float a, float b) {
  uint32_t ua = __float_as_uint(a), ub = __float_as_uint(b);
  ua += 0x7FFFu + ((ua >> 16) & 1u);
  ub += 0x7FFFu + ((ub >> 16) & 1u);
  return (ua >> 16) | (ub & 0xFFFF0000u);
}
__device__ __forceinline__ u16 f2bf(float a) {
  uint32_t ua = __float_as_uint(a);
  ua += 0x7FFFu + ((ua >> 16) & 1u);
  return (u16)(ua >> 16);
}
__device__ __forceinline__ float bf2f(u16 h) { return __uint_as_float(((uint32_t)h) << 16); }
__device__ __forceinline__ float bflo(uint32_t w) { return __uint_as_float(w << 16); }
__device__ __forceinline__ float bfhi(uint32_t w) { return __uint_as_float(w & 0xFFFF0000u); }
__device__ __forceinline__ float gelu_exact(float x) { return 0.5f * x * (1.0f + erff(x * 0.70710678118654752f)); }
__device__ __forceinline__ u32x4 cvt8(f32x4 a, f32x4 b) {
  u32x4 o; o.x = pack_bf16(a.x, a.y); o.y = pack_bf16(a.z, a.w); o.z = pack_bf16(b.x, b.y); o.w = pack_bf16(b.z, b.w); return o;
}
__device__ __forceinline__ bf16x8 as_frag(u32x4 v) { union { u32x4 u; bf16x8 f; } c; c.u = v; return c.f; }
__device__ __forceinline__ float wave_sum(float v) {
#pragma unroll
  for (int o = 32; o >= 1; o >>= 1) v += __shfl_xor(v, o);
  return v;
}

__device__ __forceinline__ void stage_half(const u16* __restrict__ base, int ld, unsigned char* dst, int tid) {
#pragma unroll
  for (int i = 0; i < 4; i++) {
    const int b = tid * 16 + i * 4096;
    const int st = b >> 10, sb = b & 1023, swz = sb ^ (((sb >> 9) & 1) << 5);
    const int R = (st >> 1) * 16 + (swz >> 6), C = (st & 1) * 32 + ((swz & 63) >> 1);
    __builtin_amdgcn_global_load_lds((const unsigned*)(base + (size_t)R * ld + C), (unsigned*)(dst + b), 16, 0, 0);
  }
}
#define WAIT_VM(n) asm volatile("s_waitcnt vmcnt(" #n ")" ::: "memory")

__device__ __forceinline__ void gemm128(const u16* __restrict__ A, int lda, const u16* __restrict__ Bt, int ldb, int K,
                                        u16* lds, f32x4 (&acc)[4][4]) {
  const int tid = tid_opaque(), lane = tid & 63, w = tid >> 6;
  const int wm = w >> 1, wn = w & 1, fr = lane & 15, fq = lane >> 4;
#pragma unroll
  for (int i = 0; i < 4; i++)
#pragma unroll
    for (int j = 0; j < 4; j++) acc[i][j] = f32x4{0.f, 0.f, 0.f, 0.f};
  unsigned char* L = (unsigned char*)lds;
  const int nk = K >> 6;
  stage_half(A, lda, L, tid);
  stage_half(Bt, ldb, L + 16384, tid);
  stage_half(A + 64, lda, L + 32768, tid);
  stage_half(Bt + 64, ldb, L + 49152, tid);
  const int laneoff = fr * 64 + ((fq ^ ((fr >> 3) << 1)) << 4);
  const unsigned char* rA = L + wm * 8192 + laneoff;
  const unsigned char* rB = L + 16384 + wn * 8192 + laneoff;
  for (int kt = 0; kt < nk; kt++) {
    const int cur = (kt & 1) * 32768;
    if (kt + 1 < nk) WAIT_VM(8); else WAIT_VM(0);
    __builtin_amdgcn_s_barrier();
    asm volatile("" ::: "memory");
#pragma unroll
    for (int ks = 0; ks < 2; ks++) {
      bf16x8 af[4], bfr[4];
#pragma unroll
      for (int i = 0; i < 4; i++) af[i] = *(const bf16x8*)(rA + cur + (i * 2 + ks) * 1024);
#pragma unroll
      for (int j = 0; j < 4; j++) bfr[j] = *(const bf16x8*)(rB + cur + (j * 2 + ks) * 1024);
#pragma unroll
      for (int i = 0; i < 4; i++)
#pragma unroll
        for (int j = 0; j < 4; j++) acc[i][j] = __builtin_amdgcn_mfma_f32_16x16x32_bf16(af[i], bfr[j], acc[i][j], 0, 0, 0);
    }
    asm volatile("s_waitcnt lgkmcnt(0)" ::: "memory");
    __builtin_amdgcn_s_barrier();
    asm volatile("" ::: "memory");
    if (kt + 2 < nk) {
      stage_half(A + (kt + 2) * 64, lda, L + cur, tid);
      stage_half(Bt + (kt + 2) * 64, ldb, L + cur + 16384, tid);
    }
  }
  __syncthreads();
}

__device__ __forceinline__ void transpose_tile(const float* __restrict__ src, u16* __restrict__ dst, int K, int N, int k0, int n0, float* tl) {
  const int tid = tid_opaque();
#pragma unroll
  for (int i = 0; i < 4; i++) {
    int r = (tid >> 4) + i * 16, c = (tid & 15) * 4;
    f32x4 v = *(const f32x4*)(src + (size_t)(k0 + r) * N + n0 + c);
    tl[r * 65 + c] = v.x; tl[r * 65 + c + 1] = v.y; tl[r * 65 + c + 2] = v.z; tl[r * 65 + c + 3] = v.w;
  }
  __syncthreads();
  const int n = tid >> 2, kc = (tid & 3) * 16;
  uint32_t o[8];
#pragma unroll
  for (int e = 0; e < 8; e++) o[e] = pack_bf16(tl[(kc + 2 * e) * 65 + n], tl[(kc + 2 * e + 1) * 65 + n]);
  u32x4* d = (u32x4*)(dst + (size_t)(n0 + n) * K + k0 + kc);
  d[0] = u32x4{o[0], o[1], o[2], o[3]};
  d[1] = u32x4{o[4], o[5], o[6], o[7]};
  __syncthreads();
}

__device__ __forceinline__ void convert_span(const float* __restrict__ s, u16* __restrict__ d, float* __restrict__ fcopy, size_t n8) {
  const size_t stride = (size_t)gridDim.x * 256;
  for (size_t g0 = (size_t)bid_opaque() * 256 + tid_opaque(); g0 < n8; g0 += stride * 4) {
    f32x4 a[4], b[4];
#pragma unroll
    for (int u = 0; u < 4; u++) {
      const size_t g = g0 + u * stride;
      if (g < n8) { a[u] = ((const f32x4*)s)[2 * g]; b[u] = ((const f32x4*)s)[2 * g + 1]; }
    }
#pragma unroll
    for (int u = 0; u < 4; u++) {
      const size_t g = g0 + u * stride;
      if (g < n8) {
        ((u32x4*)d)[g] = cvt8(a[u], b[u]);
        if (fcopy) { ((f32x4*)fcopy)[2 * g] = a[u]; ((f32x4*)fcopy)[2 * g + 1] = b[u]; }
      }
    }
  }
}
__device__ __forceinline__ void convert_span_fp6(const float* __restrict__ s, unsigned char* __restrict__ d, size_t gbeg, size_t n32, float sc) {
  const size_t stride = (size_t)gridDim.x * 256;
  for (size_t g0 = gbeg + (size_t)bid_opaque() * 256 + tid_opaque(); g0 < n32; g0 += stride * 2) {
    f32x4 a[2][8];
#pragma unroll
    for (int u = 0; u < 2; u++) {
      const size_t g = g0 + u * stride;
      if (g < n32) {
#pragma unroll
        for (int q = 0; q < 8; q++) a[u][q] = __builtin_nontemporal_load(((const f32x4*)s) + 8 * g + q);
      }
    }
#pragma unroll
    for (int u = 0; u < 2; u++) {
      const size_t g = g0 + u * stride;
      if (g < n32) {
        f32x16 lo, hi;
#pragma unroll
        for (int q = 0; q < 4; q++)
#pragma unroll
          for (int e = 0; e < 4; e++) {
            const int idx = q * 4 + e;
            lo[idx] = a[u][idx >> 1][(idx & 1) * 2] * sc; hi[idx] = a[u][idx >> 1][(idx & 1) * 2 + 1] * sc;
          }
        const u32x6 pk = __builtin_amdgcn_cvt_scalef32_2xpk16_fp6_f32(lo, hi, 1.0f);
        u32x2* dp = (u32x2*)(d + (g >> 5) * 1280 + (g & 31) * 24);
        dp[0] = u32x2{pk[0], pk[1]}; dp[1] = u32x2{pk[2], pk[3]}; dp[2] = u32x2{pk[4], pk[5]};
      }
    }
  }
}

__device__ __forceinline__ void convert_span_fp4(const float* __restrict__ s, unsigned char* __restrict__ d, size_t gbeg, size_t n32, float sc) {
  const size_t stride = (size_t)gridDim.x * 256;
  for (size_t g0 = gbeg + (size_t)bid_opaque() * 256 + tid_opaque(); g0 < n32; g0 += stride * 2) {
    f32x4 a[2][8];
#pragma unroll
    for (int u = 0; u < 2; u++) {
      const size_t g = g0 + u * stride;
      if (g < n32) {
#pragma unroll
        for (int q = 0; q < 8; q++) a[u][q] = __builtin_nontemporal_load(((const f32x4*)s) + 8 * g + q);
      }
    }
#pragma unroll
    for (int u = 0; u < 2; u++) {
      const size_t g = g0 + u * stride;
      if (g < n32) {
        u32x4 o;
#pragma unroll
        for (int wd = 0; wd < 4; wd++) {
          unsigned wv = 0;
          wv = __builtin_amdgcn_cvt_scalef32_pk_fp4_f32(wv, a[u][2 * wd].x * sc, a[u][2 * wd].y * sc, 1.0f, 0);
          wv = __builtin_amdgcn_cvt_scalef32_pk_fp4_f32(wv, a[u][2 * wd].z * sc, a[u][2 * wd].w * sc, 1.0f, 1);
          wv = __builtin_amdgcn_cvt_scalef32_pk_fp4_f32(wv, a[u][2 * wd + 1].x * sc, a[u][2 * wd + 1].y * sc, 1.0f, 2);
          wv = __builtin_amdgcn_cvt_scalef32_pk_fp4_f32(wv, a[u][2 * wd + 1].z * sc, a[u][2 * wd + 1].w * sc, 1.0f, 3);
          o[wd] = wv;
        }
        *(u32x4*)(d + (g >> 5) * 1280 + 768 + (g & 31) * 16) = o;
      }
    }
  }
}

__device__ __forceinline__ int xcd_tile(int t, int ntiles) { return (t & 7) * (ntiles >> 3) + (t >> 3); }

__device__ __forceinline__ void convert_tables_part(PP p, int layer, int part) {
  const size_t lo = part == 0 ? 0 : (part == 1 ? 174763 : 349526), hi = part == 0 ? 174763 : (part == 1 ? 349526 : 524288);
  const size_t g0 = (size_t)layer * 524288 + lo;
  convert_span_fp6(p->peer_u, p->ub, g0, g0 + (hi - lo), PEER_SU);
  convert_span_fp4(p->peer_v, p->ub, g0, g0 + (hi - lo), PEER_SV);
}

__device__ __forceinline__ void phase_prologue(PP p, unsigned char* smem) {
  float* tl = (float*)smem;
  for (int t = bid_opaque(); t < 5248; t += gridDim.x) {
    const float* src; u16* dst; int N, tt;
    if (t < 768) { tt = t; N = 1536; src = p->a_w_in; dst = p->wT_a_in; }
    else if (t < 1664) { tt = t - 768; N = 1792; src = p->b_w_in; dst = p->wT_b_in; }
    else if (t < 2176) { tt = t - 1664; N = 512; src = p->w_mem_kv; dst = p->wT_memkv; }
    else if (t < 3200) { tt = t - 2176; N = 1024; src = p->w_out; dst = p->wT_out; }
    else { tt = t - 3200; N = 2048; src = p->peer_w_q; dst = p->wT_pq; }
    const int ntn = N >> 6, per = 16 * ntn;
    const int mat = tt / per, r = tt % per, kt = r / ntn, nt = r % ntn;
    transpose_tile(src + (size_t)mat * 1024 * N, dst + (size_t)mat * 1024 * N, 1024, N, kt * 64, nt * 64, tl);
  }
  convert_span(p->peer_subkeys, p->subk, nullptr, 131072);
  convert_span(p->mem_prompt, p->memb, nullptr, 65536);
  convert_span(p->x_prompt, p->xb, p->xf, 2097152);
  convert_span(p->x_sample, p->xb + (size_t)T_P * 1024, p->xf + (size_t)T_P * 1024, 65536);
  for (int idx = bid_opaque() * 256 + tid_opaque(); idx < 8196 * 8; idx += gridDim.x * 256) {
    const int pos = idx >> 3, d = idx & 7;
    const double inv = c_rope_inv[d];
    double ang = (double)pos * inv;
    double n = rint(ang * 0.15915494309189535);
    double r = ang - n * 6.283185307179586476925;
    double r2 = r * r, ts = r, tc = 1.0, ss = r, cc = 1.0;
    for (int k = 0; k < 14; k++) {
      tc = -tc * r2 / (double)((2 * k + 1) * (2 * k + 2));
      ts = -ts * r2 / (double)((2 * k + 2) * (2 * k + 3));
      cc += tc; ss += ts;
    }
    p->ropecs[2 * idx] = (float)cc;
    p->ropecs[2 * idx + 1] = (float)ss;
  }
}

__device__ __forceinline__ void phase_inproj(PP p, int layer, unsigned char* smem) {
  const int jl = layer >> 1;
  const bool isA = !(layer & 1);
  const int NIN = isA ? 1536 : 1792, ntn = NIN >> 7;
  const u16* W = isA ? p->wT_a_in + (size_t)jl * 1536 * 1024 : p->wT_b_in + (size_t)jl * 1792 * 1024;
  const int ntiles = 132 * ntn, extra = (layer == 0) ? 64 : 0;
  const int tid = tid_opaque(), lane = tid & 63, w = tid >> 6, wm = w >> 1, wn = w & 1, quad = lane >> 4, lc = lane & 15;
  for (int t = bid_opaque(); t < ntiles + extra; t += gridDim.x) {
    f32x4 acc[4][4];
    if (t < ntiles) {
      const int tx = xcd_tile(t, ntiles);
      const int tm = tx / ntn, tn = tx % ntn;
      gemm128(p->xb + (size_t)tm * 128 * 1024, 1024, W + (size_t)tn * 128 * 1024, 1024, 1024, (u16*)smem, acc);
      const int rb = tm * 128 + wm * 64, cb = tn * 128 + wn * 64;
      u16* Cs = (u16*)smem;
      if (isA && tn < 8) {
        f32x2 cs[4][4];
#pragma unroll
        for (int i = 0; i < 4; i++)
#pragma unroll
          for (int r = 0; r < 4; r++) {
            const int row = rb + i * 16 + quad * 4 + r;
            const int pos = row < T_P ? (row & 8191) : 8192 + ((row - T_P) & 3);
            cs[i][r] = *(const f32x2*)(p->ropecs + (size_t)(pos * 8 + (lc & 7)) * 2);
          }
#pragma unroll
        for (int i = 0; i < 4; i++)
#pragma unroll
          for (int r = 0; r < 4; r++) {
            const float v = acc[i][0][r];
            const float partner = __shfl_xor(v, 8);
            acc[i][0][r] = (lc < 8) ? (v * cs[i][r].x - partner * cs[i][r].y) : (v * cs[i][r].x + partner * cs[i][r].y);
          }
      }
      if (!isA && tn < 12) {
#pragma unroll
        for (int i = 0; i < 4; i++)
#pragma unroll
          for (int j = 0; j < 4; j++)
#pragma unroll
            for (int r = 0; r < 4; r++) acc[i][j][r] = gelu_exact(acc[i][j][r]);
      }
#pragma unroll
      for (int i = 0; i < 4; i++)
#pragma unroll
        for (int j = 0; j < 4; j++)
#pragma unroll
          for (int r = 0; r < 4; r++) Cs[(wm * 64 + i * 16 + quad * 4 + r) * 136 + wn * 64 + j * 16 + lc] = f2bf(acc[i][j][r]);
      if (isA && tn >= 6 && tn < 10) {
        float* okp = (tn < 8) ? p->swa_k_prompt : p->swa_v_prompt;
        float* oks = (tn < 8) ? p->swa_k_sample : p->swa_v_sample;
        const int cko = (tn < 8) ? 768 : 1024;
#pragma unroll
        for (int i = 0; i < 4; i++)
#pragma unroll
          for (int r = 0; r < 4; r++) {
            const int row = rb + i * 16 + quad * 4 + r;
            float* dst = nullptr;
            if (row < T_P) {
              const int b = row >> 13, s2 = row & 8191;
              if (s2 >= 8064) dst = okp + ((size_t)(jl * 2 + b) * 128 + (s2 - 8064)) * 256;
            } else {
              dst = oks + ((size_t)jl * 512 + (row - T_P)) * 256;
            }
            if (dst) {
#pragma unroll
              for (int j = 0; j < 4; j++) dst[cb + j * 16 + lc - cko] = acc[i][j][r];
            }
          }
      }
      __syncthreads();
#pragma unroll
      for (int it = 0; it < 8; it++) {
        const int row = it * 16 + (tid >> 4), ch = tid & 15;
        *(u32x4*)(p->z + (size_t)(tm * 128 + row) * ZLD + tn * 128 + ch * 8) = *(const u32x4*)(Cs + row * 136 + ch * 8);
      }
      __syncthreads();
    } else {
      const int t2 = t - ntiles, l = t2 >> 4, tm = (t2 >> 2) & 3, tn = t2 & 3;
      gemm128(p->memb + (size_t)tm * 128 * 1024, 1024, p->wT_memkv + ((size_t)l * 512 + tn * 128) * 1024, 1024, 1024, (u16*)smem, acc);
      const int rb = tm * 128 + wm * 64, cb = tn * 128 + wn * 64;
#pragma unroll
      for (int i = 0; i < 4; i++)
#pragma unroll
        for (int j = 0; j < 4; j++)
#pragma unroll
          for (int r = 0; r < 4; r++) {
            const int row = rb + i * 16 + quad * 4 + r, col = cb + j * 16 + lc;
            const float v = acc[i][j][r];
            const int kv = col >> 8, c2 = col & 255;
            float* o = kv ? p->mem_v_prompt : p->mem_k_prompt;
            o[((size_t)l * 512 + row) * 256 + c2] = v;
            p->mkvp[((size_t)(l * 2 + kv) * 512 + row) * 256 + c2] = f2bf(v);
          }
    }
  }
  convert_tables_part(p, layer, 0);
}

template <int NK, bool SINK, int NSUB, class FK, class FV, class FQ, class FM, class FS, class FO>
__device__ __forceinline__ void attn_core(u16* lds, int nrows, FK loadK, FV loadV, FQ loadQ, FM allowed, FS sinkf, FO outp) {
  const int tid = tid_opaque(), lane = tid & 63, w = tid >> 6, quad = lane >> 4, lc = lane & 15;
  u16* Ks = lds;
  u16* Vt = lds + 256 * 72;
  {
    constexpr int NIT = NK * 8 / 256;
    u32x4 kreg[NIT], vreg[NIT];
#pragma unroll
    for (int it = 0; it < NIT; it++) {
      const int c = tid + it * 256, kk = c >> 3, ch = c & 7;
      kreg[it] = loadK(kk, ch);
      vreg[it] = loadV(kk, ch);
    }
#pragma unroll
    for (int it = 0; it < NIT; it++) {
      const int c = tid + it * 256, kk = c >> 3, ch = c & 7;
      *(u32x4*)(Ks + kk * 72 + ch * 8) = kreg[it];
      const u32x4 vv = vreg[it];
      u16* vd = Vt + (ch * 8) * 264 + kk;
      vd[0 * 264] = (u16)(vv.x & 0xFFFF); vd[1 * 264] = (u16)(vv.x >> 16);
      vd[2 * 264] = (u16)(vv.y & 0xFFFF); vd[3 * 264] = (u16)(vv.y >> 16);
      vd[4 * 264] = (u16)(vv.z & 0xFFFF); vd[5 * 264] = (u16)(vv.z >> 16);
      vd[6 * 264] = (u16)(vv.w & 0xFFFF); vd[7 * 264] = (u16)(vv.w >> 16);
    }
  }
  __syncthreads();
  const bool active = (w * 16 < nrows);
  constexpr int NT = NK / 16;
  if (active) {
    const int row = w * 16 + lc;
    bf16x8 qn0 = as_frag(loadQ(0, row, quad * 8)), qn1 = as_frag(loadQ(0, row, 32 + quad * 8));
#pragma unroll 1
    for (int sub = 0; sub < NSUB; sub++) {
      bf16x8 qf[1][2];
      qf[0][0] = qn0; qf[0][1] = qn1;
      if (sub + 1 < NSUB) { qn0 = as_frag(loadQ(sub + 1, row, quad * 8)); qn1 = as_frag(loadQ(sub + 1, row, 32 + quad * 8)); }
      f32x4 s[NT];
#pragma unroll
      for (int nt = 0; nt < NT; nt++) {
        s[nt] = f32x4{0.f, 0.f, 0.f, 0.f};
#pragma unroll
        for (int ks = 0; ks < 2; ks++) {
          const bf16x8 kf = *(const bf16x8*)(Ks + (nt * 16 + lc) * 72 + ks * 32 + quad * 8);
          s[nt] = __builtin_amdgcn_mfma_f32_16x16x32_bf16(kf, qf[0][ks], s[nt], 0, 0, 0);
        }
      }
      __builtin_amdgcn_sched_barrier(0);
      const float sk = SINK ? sinkf(sub, row) : -3.0e38f;
      float m = sk;
#pragma unroll
      for (int nt = 0; nt < NT; nt++)
#pragma unroll
        for (int r = 0; r < 4; r++) {
          const float v = allowed(sub, row, nt * 16 + quad * 4 + r) ? s[nt][r] * 0.125f : -1.0e30f;
          s[nt][r] = v;
          m = fmaxf(m, v);
        }
      m = fmaxf(m, __shfl_xor(m, 16)); m = fmaxf(m, __shfl_xor(m, 32));
      float sum = 0.f;
#pragma unroll
      for (int nt = 0; nt < NT; nt++)
#pragma unroll
        for (int r = 0; r < 4; r++) { const float e = __expf(s[nt][r] - m); s[nt][r] = e; sum += e; }
      sum += __shfl_xor(sum, 16); sum += __shfl_xor(sum, 32);
      if (SINK) sum += __expf(sk - m);
      const float inv = 1.0f / sum;
      __builtin_amdgcn_sched_barrier(0);
      f32x4 o[4];
#pragma unroll
      for (int dt = 0; dt < 4; dt++) o[dt] = f32x4{0.f, 0.f, 0.f, 0.f};
#pragma unroll
      for (int kk = 0; kk < NT / 2; kk++) {
        u32x4 pp;
        pp.x = pack_bf16(s[2 * kk][0] * inv, s[2 * kk][1] * inv); pp.y = pack_bf16(s[2 * kk][2] * inv, s[2 * kk][3] * inv);
        pp.z = pack_bf16(s[2 * kk + 1][0] * inv, s[2 * kk + 1][1] * inv); pp.w = pack_bf16(s[2 * kk + 1][2] * inv, s[2 * kk + 1][3] * inv);
        const bf16x8 pf = as_frag(pp);
#pragma unroll
        for (int dt = 0; dt < 4; dt++) {
          const u16* vr = Vt + (dt * 16 + lc) * 264 + kk * 32 + quad * 4;
          const u32x2 v0 = *(const u32x2*)vr, v1 = *(const u32x2*)(vr + 16);
          const bf16x8 vf = as_frag(u32x4{v0.x, v0.y, v1.x, v1.y});
          o[dt] = __builtin_amdgcn_mfma_f32_16x16x32_bf16(vf, pf, o[dt], 0, 0, 0);
        }
        __builtin_amdgcn_sched_barrier(0);
      }
      if (row < nrows) {
        u16* op = outp(sub, row);
#pragma unroll
        for (int dt = 0; dt < 4; dt++)
          *(u32x2*)(op + dt * 16 + quad * 4) = u32x2{pack_bf16(o[dt][0], o[dt][1]), pack_bf16(o[dt][2], o[dt][3])};
      }
    }
  }
  __syncthreads();
}

__device__ __forceinline__ u32x4 ld_f32x8_as_bf16(const float* ptr) {
  const f32x4 a = *(const f32x4*)ptr, b = *(const f32x4*)(ptr + 4);
  return cvt8(a, b);
}

__device__ __forceinline__ void sg_prompt_item(PP p, int jl, int item, unsigned char* smem) {
  const int tid = tid_opaque(), lane = tid & 63, w = tid >> 6, quad = lane >> 4, lc = lane & 15;
  float* stats = (float*)smem;
  float* lnp = (float*)(smem + 1024);
  u16* Vt = (u16*)(smem + 2560);
  const int tok0 = (item >> 2) * 128;
  const int g = item & 3;
  for (int bt = 0; bt < 4; bt++) {
    const int srow = w * 32 + bt * 8 + (lane >> 3);
    const u16* zr = p->z + (size_t)(tok0 + srow) * ZLD + 768 + (lane & 7) * 96;
    u32x4 q[12];
#pragma unroll
    for (int i = 0; i < 12; i++) q[i] = *(const u32x4*)(zr + i * 8);
    float sum = 0.f;
#pragma unroll
    for (int i = 0; i < 12; i++)
#pragma unroll
      for (int e = 0; e < 4; e++) sum += bflo(q[i][e]) + bfhi(q[i][e]);
    sum += __shfl_xor(sum, 1); sum += __shfl_xor(sum, 2); sum += __shfl_xor(sum, 4);
    const float mu = sum * (1.0f / 768.0f);
    float sq = 0.f;
#pragma unroll
    for (int i = 0; i < 12; i++)
#pragma unroll
      for (int e = 0; e < 4; e++) { const float d0 = bflo(q[i][e]) - mu, d1 = bfhi(q[i][e]) - mu; sq += d0 * d0 + d1 * d1; }
    sq += __shfl_xor(sq, 1); sq += __shfl_xor(sq, 2); sq += __shfl_xor(sq, 4);
    if ((lane & 7) == 0) { stats[srow * 2] = mu; stats[srow * 2 + 1] = rsqrtf(sq * (1.0f / 768.0f) + LN_EPS_F); }
  }
  if (tid < 192) { lnp[tid * 2] = p->b_v_ln_g[jl * 768 + g * 192 + tid]; lnp[tid * 2 + 1] = p->b_v_ln_b[jl * 768 + g * 192 + tid]; }
  __syncthreads();
  {
    {
      u32x4 q[12];
#pragma unroll
      for (int it = 0; it < 12; it++) {
        const int c2 = tid + it * 256, s2 = c2 / 24, ch = c2 % 24;
        q[it] = *(const u32x4*)(p->z + (size_t)(tok0 + s2) * ZLD + 768 + g * 192 + ch * 8);
      }
#pragma unroll
      for (int it = 0; it < 12; it++) {
        const int c2 = tid + it * 256, s2 = c2 / 24, ch = c2 % 24;
        const float mu = stats[s2 * 2], rs = stats[s2 * 2 + 1];
        const float* lp = lnp + ch * 16;
        u16* vd = Vt + (ch * 8) * 136 + s2;
#pragma unroll
        for (int e = 0; e < 4; e++) {
          vd[(2 * e) * 136] = f2bf((bflo(q[it][e]) - mu) * rs * lp[4 * e] + lp[4 * e + 1]);
          vd[(2 * e + 1) * 136] = f2bf((bfhi(q[it][e]) - mu) * rs * lp[4 * e + 2] + lp[4 * e + 3]);
        }
      }
    }
    __syncthreads();
    const float* wsg = p->b_w_s + (size_t)(jl * 4 + g) * 128 * 128;
    const float* bsg = p->b_b_s + (jl * 4 + g) * 128;
    for (int hh = 0; hh < 2; hh++) {
      f32x4 acc[2][6];
#pragma unroll
      for (int i = 0; i < 2; i++)
#pragma unroll
        for (int jt = 0; jt < 6; jt++) acc[i][jt] = f32x4{0.f, 0.f, 0.f, 0.f};
#pragma unroll
      for (int i = 0; i < 2; i++) {
        const int R = w * 32 + i * 16;
#pragma unroll
        for (int ks = 0; ks < 4; ks++) {
          if (ks * 32 <= R + 15) {
            const int t = R + lc, s0 = ks * 32 + quad * 8;
            const f32x4 a0 = *(const f32x4*)(wsg + t * 128 + s0), a1 = *(const f32x4*)(wsg + t * 128 + s0 + 4);
            float av[8] = {a0.x, a0.y, a0.z, a0.w, a1.x, a1.y, a1.z, a1.w};
#pragma unroll
            for (int e = 0; e < 8; e++) av[e] = (s0 + e <= t) ? av[e] : 0.f;
            u32x4 au; au.x = pack_bf16(av[0], av[1]); au.y = pack_bf16(av[2], av[3]); au.z = pack_bf16(av[4], av[5]); au.w = pack_bf16(av[6], av[7]);
            const bf16x8 a = as_frag(au);
#pragma unroll
            for (int jt = 0; jt < 6; jt++) {
              const bf16x8 b = *(const bf16x8*)(Vt + ((hh * 6 + jt) * 16 + lc) * 136 + ks * 32 + quad * 8);
              acc[i][jt] = __builtin_amdgcn_mfma_f32_16x16x32_bf16(a, b, acc[i][jt], 0, 0, 0);
            }
          }
        }
      }
#pragma unroll
      for (int i = 0; i < 2; i++) {
        float bs[4];
        u16 zu[4][6];
#pragma unroll
        for (int r = 0; r < 4; r++) {
          const int t = w * 32 + i * 16 + quad * 4 + r;
          bs[r] = bsg[t];
          const u16* zp = p->z + (size_t)(tok0 + t) * ZLD + g * 192 + hh * 96;
#pragma unroll
          for (int jt = 0; jt < 6; jt++) zu[r][jt] = zp[jt * 16 + lc];
        }
#pragma unroll
        for (int r = 0; r < 4; r++) {
          const int t = w * 32 + i * 16 + quad * 4 + r;
          u16* mo = p->mix + (size_t)(tok0 + t) * 1024 + g * 192 + hh * 96;
#pragma unroll
          for (int jt = 0; jt < 6; jt++) mo[jt * 16 + lc] = f2bf(bf2f(zu[r][jt]) * (acc[i][jt][r] + bs[r]));
        }
      }
    }
    __syncthreads();
  }
}

__device__ __forceinline__ void sg_sample_item(PP p, int jl, int b, unsigned char* smem) {
  const int tid = tid_opaque(), lane = tid & 63, w = tid >> 6;
  float* vln = (float*)smem;
  {
    const int tok = T_P + b * 4 + w;
    const u16* zr = p->z + (size_t)tok * ZLD + 768;
    float v[12];
#pragma unroll
    for (int i = 0; i < 3; i++) {
      const u32x2 q = *(const u32x2*)(zr + i * 256 + lane * 4);
      v[i * 4 + 0] = bflo(q.x); v[i * 4 + 1] = bfhi(q.x); v[i * 4 + 2] = bflo(q.y); v[i * 4 + 3] = bfhi(q.y);
    }
    float sum = 0.f;
#pragma unroll
    for (int i = 0; i < 12; i++) sum += v[i];
    const float mu = wave_sum(sum) * (1.0f / 768.0f);
    float sq = 0.f;
#pragma unroll
    for (int i = 0; i < 12; i++) { const float d = v[i] - mu; sq += d * d; }
    const float rs = rsqrtf(wave_sum(sq) * (1.0f / 768.0f) + LN_EPS_F);
    float* og = p->sg_v_sample + ((size_t)(jl * 128 + b) * 4 + w) * 768;
    f32x4 lg[3], lb[3];
#pragma unroll
    for (int i = 0; i < 3; i++) { lg[i] = *(const f32x4*)(p->b_v_ln_g + jl * 768 + i * 256 + lane * 4); lb[i] = *(const f32x4*)(p->b_v_ln_b + jl * 768 + i * 256 + lane * 4); }
#pragma unroll
    for (int i = 0; i < 3; i++) {
      f32x4 o;
      o.x = (v[i * 4 + 0] - mu) * rs * lg[i].x + lb[i].x; o.y = (v[i * 4 + 1] - mu) * rs * lg[i].y + lb[i].y;
      o.z = (v[i * 4 + 2] - mu) * rs * lg[i].z + lb[i].z; o.w = (v[i * 4 + 3] - mu) * rs * lg[i].w + lb[i].w;
      *(f32x4*)(vln + w * 768 + i * 256 + lane * 4) = o;
      *(f32x4*)(og + i * 256 + lane * 4) = o;
    }
  }
  __syncthreads();
  {
    float wv[3][10], bsv[3][4], zu[3][4];
#pragma unroll
    for (int k = 0; k < 3; k++) {
      const int c = tid + k * 256, g = c / 192;
      const float* wsg = p->b_w_s + (size_t)(jl * 4 + g) * 128 * 128;
      const float* bsg = p->b_b_s + (jl * 4 + g) * 128;
      int n = 0;
#pragma unroll
      for (int t = 0; t < 4; t++) {
        bsv[k][t] = bsg[t];
        zu[k][t] = bf2f(p->z[(size_t)(T_P + b * 4 + t) * ZLD + c]);
#pragma unroll
        for (int s2 = 0; s2 <= t; s2++) wv[k][n++] = wsg[t * 128 + s2];
      }
    }
#pragma unroll
    for (int k = 0; k < 3; k++) {
      const int c = tid + k * 256;
      int n = 0;
#pragma unroll
      for (int t = 0; t < 4; t++) {
        float sg = bsv[k][t];
#pragma unroll
        for (int s2 = 0; s2 <= t; s2++) sg += wv[k][n++] * vln[s2 * 768 + c];
        p->mix[(size_t)(T_P + b * 4 + t) * 1024 + c] = f2bf(zu[k][t] * sg);
      }
    }
  }
  __syncthreads();
}

__device__ __forceinline__ void mem_prompt_item(PP p, int layer, int it, unsigned char* smem) {
  const int qoff = (layer & 1) ? 1536 : 1280;
  const int mh = it & 3, tp = it >> 2;
  const int tok0 = tp * 128, b = tok0 >> 13;
  const u16* kb = p->mkvp + ((size_t)(layer * 2 + 0) * 512 + b * 256) * 256 + mh * 64;
  const u16* vb = p->mkvp + ((size_t)(layer * 2 + 1) * 512 + b * 256) * 256 + mh * 64;
  const u16* qb = p->z + (size_t)tok0 * ZLD + qoff + mh * 64;
  u16* ob = p->mix + (size_t)tok0 * 1024 + 768 + mh * 64;
  attn_core<256, false, 2>((u16*)smem, 64,
      [&](int kk, int ch) { return *(const u32x4*)(kb + (size_t)kk * 256 + ch * 8); },
      [&](int kk, int ch) { return *(const u32x4*)(vb + (size_t)kk * 256 + ch * 8); },
      [&](int sub, int row, int ko) { return *(const u32x4*)(qb + (size_t)(sub * 64 + row) * ZLD + ko); },
      [&](int, int, int) { return true; },
      [&](int, int) { return 0.f; },
      [&](int sub, int row) { return ob + (size_t)(sub * 64 + row) * 1024; });
}

__device__ __forceinline__ void mem_sample_item(PP p, int layer, int it, unsigned char* smem) {
  const int qoff = (layer & 1) ? 1536 : 1280;
  const int mh = it & 3, b = it >> 2;
  const float* kb = p->cache_mem_k + ((size_t)(layer * 128 + b) * 256) * 256 + mh * 64;
  const float* vb = p->cache_mem_v + ((size_t)(layer * 128 + b) * 256) * 256 + mh * 64;
  const int tok0 = T_P + b * 4;
  const u16* qb = p->z + (size_t)tok0 * ZLD + qoff + mh * 64;
  u16* ob = p->mix + (size_t)tok0 * 1024 + 768 + mh * 64;
  attn_core<256, false, 1>((u16*)smem, 4,
      [&](int kk, int ch) { return ld_f32x8_as_bf16(kb + (size_t)kk * 256 + ch * 8); },
      [&](int kk, int ch) { return ld_f32x8_as_bf16(vb + (size_t)kk * 256 + ch * 8); },
      [&](int, int row, int ko) { return row < 4 ? *(const u32x4*)(qb + (size_t)row * ZLD + ko) : zero4(); },
      [&](int, int, int) { return true; },
      [&](int, int) { return 0.f; },
      [&](int, int row) { return ob + (size_t)row * 1024; });
}

__device__ __forceinline__ void swa_prompt_item(PP p, int jl, int it, unsigned char* smem) {
  const int kvh = it & 3, hb = it >> 2;
  const int tok0 = hb * 64, b = tok0 >> 13, q0 = tok0 & 8191;
  const u16* zb = p->z + (size_t)(b * 8192) * ZLD;
  const u16* qb = p->z + (size_t)tok0 * ZLD + kvh * 192;
  u16* ob = p->mix + (size_t)tok0 * 1024 + kvh * 192;
  const float sk0 = p->a_sink[jl * 12 + kvh * 3], sk1 = p->a_sink[jl * 12 + kvh * 3 + 1], sk2 = p->a_sink[jl * 12 + kvh * 3 + 2];
  attn_core<192, true, 3>((u16*)smem, 64,
      [&](int kk, int ch) { const int kp = q0 - 128 + kk; return kp >= 0 ? *(const u32x4*)(zb + (size_t)kp * ZLD + 768 + kvh * 64 + ch * 8) : zero4(); },
      [&](int kk, int ch) { const int kp = q0 - 128 + kk; return kp >= 0 ? *(const u32x4*)(zb + (size_t)kp * ZLD + 1024 + kvh * 64 + ch * 8) : zero4(); },
      [&](int sub, int row, int ko) { return *(const u32x4*)(qb + (size_t)row * ZLD + sub * 64 + ko); },
      [&](int, int row, int kk) { const int qp = q0 + row, kp = q0 - 128 + kk; return kp >= 0 && kp <= qp && qp - kp < 128; },
      [&](int sub, int) { return sub == 0 ? sk0 : (sub == 1 ? sk1 : sk2); },
      [&](int sub, int row) { return ob + (size_t)row * 1024 + sub * 64; });
}

__device__ __forceinline__ void swa_sample_item(PP p, int jl, int it, unsigned char* smem) {
  const int kvh = it & 3, b = it >> 2;
  const float* ck = p->cache_swa_k + ((size_t)(jl * 128 + b) * 128) * 256 + kvh * 64;
  const float* cv = p->cache_swa_v + ((size_t)(jl * 128 + b) * 128) * 256 + kvh * 64;
  const int tok0 = T_P + b * 4;
  const u16* zb = p->z + (size_t)tok0 * ZLD;
  u16* ob = p->mix + (size_t)tok0 * 1024;
  const float* sk = p->a_sink + jl * 12 + kvh * 3;
  attn_core<160, true, 1>((u16*)smem, 12,
      [&](int kk, int ch) {
        if (kk < 128) return ld_f32x8_as_bf16(ck + (size_t)kk * 256 + ch * 8);
        if (kk < 132) return *(const u32x4*)(zb + (size_t)(kk - 128) * ZLD + 768 + kvh * 64 + ch * 8);
        return zero4(); },
      [&](int kk, int ch) {
        if (kk < 128) return ld_f32x8_as_bf16(cv + (size_t)kk * 256 + ch * 8);
        if (kk < 132) return *(const u32x4*)(zb + (size_t)(kk - 128) * ZLD + 1024 + kvh * 64 + ch * 8);
        return zero4(); },
      [&](int, int row, int ko) { return row < 12 ? *(const u32x4*)(zb + (size_t)(row / 3) * ZLD + (kvh * 3 + row % 3) * 64 + ko) : zero4(); },
      [&](int, int row, int kk) { const int t = row / 3; return kk < 128 ? (kk > t) : (kk < 132 && (kk - 128) <= t); },
      [&](int, int row) { return row < 12 ? sk[row % 3] : 0.f; },
      [&](int, int row) { return ob + (size_t)(row / 3) * 1024 + (kvh * 3 + row % 3) * 64; });
}

__device__ __forceinline__ void phase_mixer(PP p, int layer, unsigned char* smem) {
  const int jl = layer >> 1;
  if (!(layer & 1)) {
    for (int it = bid_opaque(); it < 2560; it += gridDim.x) {
      if (it < 1024) swa_prompt_item(p, jl, it, smem);
      else if (it < 1536) mem_prompt_item(p, layer, it - 1024, smem);
      else if (it < 2048) swa_sample_item(p, jl, it - 1536, smem);
      else mem_sample_item(p, layer, it - 2048, smem);
    }
  } else {
    for (int it = bid_opaque(); it < 1664; it += gridDim.x) {
      if (it < 512) sg_prompt_item(p, jl, it, smem);
      else if (it < 1024) mem_prompt_item(p, layer, it - 512, smem);
      else if (it < 1152) sg_sample_item(p, jl, it - 1024, smem);
      else mem_sample_item(p, layer, it - 1152, smem);
    }
  }
}

__device__ __forceinline__ void phase_outproj(PP p, int layer, unsigned char* smem) {
  const int tid = tid_opaque(), lane = tid & 63, w = tid >> 6, wm = w >> 1, wn = w & 1, quad = lane >> 4, lc = lane & 15;
  const u16* W = p->wT_out + (size_t)layer * 1024 * 1024;
  for (int t = bid_opaque(); t < 132 * 8; t += gridDim.x) {
    const int tx = xcd_tile(t, 132 * 8);
    const int tm = tx >> 3, tn = tx & 7;
    f32x4 acc[4][4];
    gemm128(p->mix + (size_t)tm * 128 * 1024, 1024, W + (size_t)tn * 128 * 1024, 1024, 1024, (u16*)smem, acc);
    float* Cs = (float*)smem;
#pragma unroll
    for (int i = 0; i < 4; i++)
#pragma unroll
      for (int j = 0; j < 4; j++)
#pragma unroll
        for (int r = 0; r < 4; r++) Cs[(wm * 64 + i * 16 + quad * 4 + r) * 132 + wn * 64 + j * 16 + lc] = acc[i][j][r];
    __syncthreads();
    const size_t gbase = (size_t)(tm * 128) * 1024 + tn * 128 + (tid & 31) * 4;
#pragma unroll
    for (int hb = 0; hb < 2; hb++) {
      f32x4 res[8];
#pragma unroll
      for (int it = 0; it < 8; it++) res[it] = *(const f32x4*)(p->xf + gbase + (size_t)((hb * 8 + it) * 8 + (tid >> 5)) * 1024);
#pragma unroll
      for (int it = 0; it < 8; it++) {
        const int row = (hb * 8 + it) * 8 + (tid >> 5);
        const f32x4 c = *(const f32x4*)(Cs + row * 132 + (tid & 31) * 4);
        *(f32x4*)(p->pre + gbase + (size_t)row * 1024) = DN_ALPHA_F * res[it] + c;
      }
    }
    __syncthreads();
  }
  convert_tables_part(p, layer, 1);
}

__device__ __forceinline__ void phase_ln1(PP p, int layer) {
  const int tid = tid_opaque(), lane = tid & 63, w = tid >> 6;
  const float* g = p->ln1_g + layer * 1024;
  const float* bb = p->ln1_b + layer * 1024;
  for (int tok = bid_opaque() * 4 + w; tok < T_ALL; tok += gridDim.x * 4) {
    float v[16];
#pragma unroll
    for (int i = 0; i < 4; i++) {
      const f32x4 q = *(const f32x4*)(p->pre + (size_t)tok * 1024 + i * 256 + lane * 4);
      v[i * 4] = q.x; v[i * 4 + 1] = q.y; v[i * 4 + 2] = q.z; v[i * 4 + 3] = q.w;
    }
    float sum = 0.f;
#pragma unroll
    for (int i = 0; i < 16; i++) sum += v[i];
    const float mu = wave_sum(sum) * (1.0f / 1024.0f);
    float sq = 0.f;
#pragma unroll
    for (int i = 0; i < 16; i++) { const float d = v[i] - mu; sq += d * d; }
    const float rs = rsqrtf(wave_sum(sq) * (1.0f / 1024.0f) + LN_EPS_F);
    f32x4 gg[4], bv[4];
#pragma unroll
    for (int i = 0; i < 4; i++) { gg[i] = *(const f32x4*)(g + i * 256 + lane * 4); bv[i] = *(const f32x4*)(bb + i * 256 + lane * 4); }
#pragma unroll
    for (int i = 0; i < 4; i++) {
      const int c = i * 256 + lane * 4;
      f32x4 o;
      o.x = (v[i * 4] - mu) * rs * gg[i].x + bv[i].x; o.y = (v[i * 4 + 1] - mu) * rs * gg[i].y + bv[i].y;
      o.z = (v[i * 4 + 2] - mu) * rs * gg[i].z + bv[i].z; o.w = (v[i * 4 + 3] - mu) * rs * gg[i].w + bv[i].w;
      *(f32x4*)(p->xf + (size_t)tok * 1024 + c) = o;
      *(u32x2*)(p->xb + (size_t)tok * 1024 + c) = u32x2{pack_bf16(o.x, o.y), pack_bf16(o.z, o.w)};
    }
  }
}

__device__ __forceinline__ void phase_peerq(PP p, int layer, unsigned char* smem) {
  const int tid = tid_opaque(), lane = tid & 63, w = tid >> 6, wm = w >> 1, wn = w & 1, quad = lane >> 4, lc = lane & 15;
  const u16* W = p->wT_pq + (size_t)layer * 2048 * 1024;
  const float* bq = p->peer_b_q + layer * 2048;
  u16* Qs = (u16*)smem;
  uint32_t* Sk = (uint32_t*)smem;
  for (int t = bid_opaque(); t < 132 * 16; t += gridDim.x) {
    const int tx = xcd_tile(t, 132 * 16);
    const int tm = tx >> 4, tn = tx & 15;
    f32x4 acc[4][4];
    gemm128(p->xb + (size_t)tm * 128 * 1024, 1024, W + (size_t)tn * 128 * 1024, 1024, 1024, (u16*)smem, acc);
#pragma unroll
    for (int i = 0; i < 4; i++)
#pragma unroll
      for (int j = 0; j < 4; j++) {
        const int col = wn * 64 + j * 16 + lc;
        const float bias = bq[tn * 128 + col];
#pragma unroll
        for (int r = 0; r < 4; r++) Qs[(wm * 64 + i * 16 + quad * 4 + r) * 136 + col] = f2bf(acc[i][j][r] + bias);
      }
    __syncthreads();
    const u16* sk = p->subk + ((size_t)layer * 16 + tn) * 128 * 128;
#pragma unroll
    for (int i = 0; i < 4; i++)
#pragma unroll
      for (int j = 0; j < 4; j++) acc[i][j] = f32x4{0.f, 0.f, 0.f, 0.f};
#pragma unroll
    for (int ks = 0; ks < 4; ks++) {
      bf16x8 af[4], bfr[4];
#pragma unroll
      for (int i = 0; i < 4; i++) af[i] = *(const bf16x8*)(Qs + (wm * 64 + i * 16 + lc) * 136 + ks * 32 + quad * 8);
#pragma unroll
      for (int j = 0; j < 4; j++) bfr[j] = *(const bf16x8*)(sk + (size_t)(wn * 64 + j * 16 + lc) * 128 + ks * 32 + quad * 8);
#pragma unroll
      for (int i = 0; i < 4; i++)
#pragma unroll
        for (int j = 0; j < 4; j++) acc[i][j] = __builtin_amdgcn_mfma_f32_16x16x32_bf16(af[i], bfr[j], acc[i][j], 0, 0, 0);
    }
    __syncthreads();
#pragma unroll
    for (int i = 0; i < 4; i++)
#pragma unroll
      for (int j = 0; j < 4; j++) {
        const int n = wn * 64 + j * 16 + lc;
#pragma unroll
        for (int r = 0; r < 4; r++) {
          const uint32_t u = __float_as_uint(acc[i][j][r]);
          const uint32_t m = (u & 0x80000000u) ? ~u : (u | 0x80000000u);
          Sk[(wm * 64 + i * 16 + quad * 4 + r) * 129 + n] = (m & ~127u) | (uint32_t)(127 - n);
        }
      }
    __syncthreads();
    if (tid < 128) {
      uint32_t k[128];
#pragma unroll
      for (int e = 0; e < 128; e++) k[e] = Sk[tid * 129 + e];
#pragma unroll
      for (int size = 2; size <= 16; size <<= 1) {
#pragma unroll
        for (int stride = size >> 1; stride > 0; stride >>= 1) {
#pragma unroll
          for (int i = 0; i < 128; i++) {
            const int j = i ^ stride;
            if (j > i) {
              const uint32_t mx = k[i] > k[j] ? k[i] : k[j], mn = k[i] > k[j] ? k[j] : k[i];
              if ((i & size) == 0) { k[i] = mx; k[j] = mn; } else { k[i] = mn; k[j] = mx; }
            }
          }
        }
      }
#pragma unroll
      for (int ng = 4; ng >= 1; ng >>= 1) {
#pragma unroll
        for (int m = 0; m < ng; m++) {
#pragma unroll
          for (int i = 0; i < 16; i++) {
            const uint32_t a = k[(2 * m) * 16 + i], b = k[(2 * m + 1) * 16 + i];
            k[m * 16 + i] = a > b ? a : b;
          }
        }
#pragma unroll
        for (int stride = 8; stride > 0; stride >>= 1) {
#pragma unroll
          for (int i = 0; i < 16 * ng; i++) {
            const int j = i ^ stride;
            if (j > i) {
              const uint32_t mx = k[i] > k[j] ? k[i] : k[j], mn = k[i] > k[j] ? k[j] : k[i];
              if ((i & 16) == 0) { k[i] = mx; k[j] = mn; } else { k[i] = mn; k[j] = mx; }
            }
          }
        }
      }
      u32x4* o = (u32x4*)(p->topk + ((size_t)(tm * 128 + tid) * 16 + tn) * 16);
#pragma unroll
      for (int q = 0; q < 4; q++) {
        u32x4 v;
#pragma unroll
        for (int e = 0; e < 4; e++) { const uint32_t b = k[q * 4 + e]; v[e] = (b & ~127u) | (127u - (b & 127u)); }
        o[q] = v;
      }
    }
    __syncthreads();
  }
  convert_tables_part(p, layer, 2);
}

__device__ __forceinline__ float dec_key(uint32_t key) {
  const uint32_t m = key & ~127u;
  return __uint_as_float((m & 0x80000000u) ? (m ^ 0x80000000u) : ~m);
}

__device__ __forceinline__ void phase_gather(PP p, int layer, unsigned char* smem) {
  const int tid = tid_opaque(), lane = tid & 63, w = tid >> 6;
  const int hl = lane & 31;
  const bool hi_half = lane >= 32;
  const unsigned char* ubl = p->ub + (size_t)layer * 16384 * 1280 + hl * 24;
  const unsigned char* vbl = p->ub + (size_t)layer * 16384 * 1280 + 768 + hl * 16;
  const float* g2 = p->ln2_g + layer * 1024;
  const float* b2 = p->ln2_b + layer * 1024;
  const int ci = c_cand[lane] >> 4, cj = c_cand[lane] & 15;
  float* xo = (layer == 3) ? p->y_out : p->xf;
  u32x2* selw = (u32x2*)smem + w * 512 + lane;
  for (int tok = bid_opaque() * 4 + w; tok < T_ALL; tok += gridDim.x * 4) {
    f32x32 x, y;
    {
      const float* xr = p->xf + (size_t)tok * 1024 + hl * 32;
#pragma unroll
      for (int i = 0; i < 8; i++) {
        const f32x4 a = *(const f32x4*)(xr + i * 4);
        x[i * 4] = a.x; x[i * 4 + 1] = a.y; x[i * 4 + 2] = a.z; x[i * 4 + 3] = a.w;
      }
    }
#pragma unroll
    for (int i = 0; i < 32; i++) y[i] = 0.f;
    u32x2 wu[8][3];
    u32x4 wv[8];
    int e[16];
    uint32_t k0n = p->topk[(size_t)tok * 256 + ci], k1n = p->topk[(size_t)tok * 256 + 16 + cj];
    for (int h = 0; h < 8; h++) {
      const uint32_t k0 = k0n, k1 = k1n;
      if (h + 1 < 8) { const uint32_t* tk = p->topk + ((size_t)tok * 16 + (h + 1) * 2) * 16; k0n = tk[ci]; k1n = tk[16 + cj]; }
      float cand = dec_key(k0) + dec_key(k1);
      int eid = (int)((k0 & 127u) * 128u + (k1 & 127u));
      uint32_t ckey;
      {
        const uint32_t u = __float_as_uint(cand);
        const uint32_t m = (u & 0x80000000u) ? ~u : (u | 0x80000000u);
        ckey = (lane < 50) ? ((m & ~63u) | (uint32_t)(63 - lane)) : 0u;
      }
      int rank = 0;
#pragma unroll
      for (int l2 = 0; l2 < 50; l2++) {
        const uint32_t o = (uint32_t)__builtin_amdgcn_readlane((int)ckey, l2);
        rank += (o > ckey) ? 1 : 0;
      }
      const int dst = (rank < 16) ? ((rank & 1) * 32 + (rank >> 1) * 4) : 1;
      const float fsel = __int_as_float(__builtin_amdgcn_ds_permute(dst * 4, __float_as_int(cand)));
      const int esel = __builtin_amdgcn_ds_permute(dst * 4, eid);
      const float f0 = __int_as_float(__builtin_amdgcn_readlane(__float_as_int(fsel), 0));
      float ev = ((lane & 3) == 0) ? __expf(fsel - f0) : 0.f;
      float es = ev;
      es += __shfl_xor(es, 4); es += __shfl_xor(es, 8); es += __shfl_xor(es, 16); es += __shfl_xor(es, 32);
      const float gate = ev / es;
      selw[h * 64] = u32x2{(uint32_t)esel, __float_as_uint(gate)};
      if (h == 0) {
#pragma unroll
        for (int k = 0; k < 16; k++) e[k] = __builtin_amdgcn_readlane(esel, (k & 1) * 32 + (k >> 1) * 4);
#pragma unroll
        for (int m = 0; m < 8; m++) {
          const u32x2* rp = (const u32x2*)(ubl + (size_t)(hi_half ? e[2 * m + 1] : e[2 * m]) * 1280);
          wu[m][0] = rp[0]; wu[m][1] = rp[1]; wu[m][2] = rp[2];
        }
#pragma unroll
        for (int m = 0; m < 8; m++) wv[m] = *(const u32x4*)(vbl + (size_t)(hi_half ? e[2 * m + 1] : e[2 * m]) * 1280);
      }
    }
    for (int h = 0; h < 8; h++) {
      float pd[8];
#pragma unroll
      for (int m = 0; m < 8; m++) {
        const u32x6 pk = {wu[m][0].x, wu[m][0].y, wu[m][1].x, wu[m][1].y, wu[m][2].x, wu[m][2].y};
        const f32x32 f = __builtin_amdgcn_cvt_scalef32_pk32_f32_fp6(pk, 1.0f);
        f32x2 a0 = {0.f, 0.f}, a1 = {0.f, 0.f};
#pragma unroll
        for (int i = 0; i < 8; i++) {
          a0 += f32x2{f[4 * i], f[4 * i + 1]} * f32x2{x[4 * i], x[4 * i + 1]};
          a1 += f32x2{f[4 * i + 2], f[4 * i + 3]} * f32x2{x[4 * i + 2], x[4 * i + 3]};
        }
        pd[m] = (a0.x + a0.y) + (a1.x + a1.y);
        __builtin_amdgcn_sched_barrier(0);
      }
      const float gate = __uint_as_float(selw[h * 64].y);
      if (h + 1 < 8) {
        const int esn = (int)selw[(h + 1) * 64].x;
#pragma unroll
        for (int k = 0; k < 16; k++) e[k] = __builtin_amdgcn_readlane(esn, (k & 1) * 32 + (k >> 1) * 4);
#pragma unroll
        for (int m = 0; m < 8; m++) {
          const u32x2* rp = (const u32x2*)(ubl + (size_t)(hi_half ? e[2 * m + 1] : e[2 * m]) * 1280);
          wu[m][0] = rp[0]; wu[m][1] = rp[1]; wu[m][2] = rp[2];
        }
      }
      __builtin_amdgcn_sched_barrier(0);
      float q4[4], q2[2], q1;
      {
        const bool hi = lane & 16;
#pragma unroll
        for (int k = 0; k < 4; k++) { const float give = hi ? pd[k] : pd[k + 4]; const float keep = hi ? pd[k + 4] : pd[k]; q4[k] = keep + __shfl_xor(give, 16); }
      }
      {
        const bool hi = lane & 8;
#pragma unroll
        for (int k = 0; k < 2; k++) { const float give = hi ? q4[k] : q4[k + 2]; const float keep = hi ? q4[k + 2] : q4[k]; q2[k] = keep + __shfl_xor(give, 8); }
      }
      {
        const bool hi = lane & 4;
        const float give = hi ? q2[0] : q2[1]; const float keep = hi ? q2[1] : q2[0];
        q1 = keep + __shfl_xor(give, 4);
      }
      q1 += __shfl_xor(q1, 2);
      q1 += __shfl_xor(q1, 1);
      const float aval = gate * gelu_exact(q1 * (1.0f / PEER_SU)) * (1.0f / PEER_SV);
      __builtin_amdgcn_sched_barrier(0);
#pragma unroll
      for (int m = 0; m < 8; m++) {
        const float alo = __int_as_float(__builtin_amdgcn_readlane(__float_as_int(aval), 4 * m));
        const float ahi = __int_as_float(__builtin_amdgcn_readlane(__float_as_int(aval), 32 + 4 * m));
        const float a = hi_half ? ahi : alo;
        const f32x2 a2 = {a, a};
#define FP4_ACC(WD, BS) { const f32x2 f = __builtin_amdgcn_cvt_scalef32_pk_f32_fp4(wv[m][WD], 1.0f, BS); \
          const f32x2 r = f32x2{y[2 * (WD * 4 + BS)], y[2 * (WD * 4 + BS) + 1]} + a2 * f; y[2 * (WD * 4 + BS)] = r.x; y[2 * (WD * 4 + BS) + 1] = r.y; }
#define FP4_ACC4(WD) FP4_ACC(WD, 0) FP4_ACC(WD, 1) FP4_ACC(WD, 2) FP4_ACC(WD, 3)
        FP4_ACC4(0) FP4_ACC4(1) FP4_ACC4(2) FP4_ACC4(3)
        __builtin_amdgcn_sched_barrier(0);
      }
      if (h + 1 < 8) {
#pragma unroll
        for (int m = 0; m < 8; m++) wv[m] = *(const u32x4*)(vbl + (size_t)(hi_half ? e[2 * m + 1] : e[2 * m]) * 1280);
      }
      __builtin_amdgcn_sched_barrier(0);
    }
    float sum = 0.f;
#pragma unroll
    for (int i = 0; i < 32; i++) { y[i] += __shfl_xor(y[i], 32); y[i] = fmaf(DN_ALPHA_F, x[i], y[i]); sum += y[i]; }
    sum += __shfl_xor(sum, 16); sum += __shfl_xor(sum, 8); sum += __shfl_xor(sum, 4); sum += __shfl_xor(sum, 2); sum += __shfl_xor(sum, 1);
    const float mu = sum * (1.0f / 1024.0f);
    float sq = 0.f;
#pragma unroll
    for (int i = 0; i < 32; i++) { const float d = y[i] - mu; sq += d * d; }
    sq += __shfl_xor(sq, 16); sq += __shfl_xor(sq, 8); sq += __shfl_xor(sq, 4); sq += __shfl_xor(sq, 2); sq += __shfl_xor(sq, 1);
    const float rs = rsqrtf(sq * (1.0f / 1024.0f) + LN_EPS_F);
    f32x4 ga[8], ba[8];
#pragma unroll
    for (int i = 0; i < 8; i++) { ga[i] = *(const f32x4*)(g2 + hl * 32 + i * 4); ba[i] = *(const f32x4*)(b2 + hl * 32 + i * 4); }
    f32x4 o[8];
#pragma unroll
    for (int i = 0; i < 8; i++) {
      o[i].x = (y[i * 4 + 0] - mu) * rs * ga[i].x + ba[i].x; o[i].y = (y[i * 4 + 1] - mu) * rs * ga[i].y + ba[i].y;
      o[i].z = (y[i * 4 + 2] - mu) * rs * ga[i].z + ba[i].z; o[i].w = (y[i * 4 + 3] - mu) * rs * ga[i].w + ba[i].w;
    }
    if (!hi_half) {
#pragma unroll
      for (int i = 0; i < 8; i++) *(f32x4*)(xo + (size_t)tok * 1024 + hl * 32 + i * 4) = o[i];
    } else {
#pragma unroll
      for (int i = 0; i < 4; i++) *(u32x4*)(p->xb + (size_t)tok * 1024 + hl * 32 + i * 8) = cvt8(o[2 * i], o[2 * i + 1]);
    }
  }
}

#define XB_TMO      128
#define XB_XCNT(j)  (256  + 64 * (j))
#define XB_XSUB(j)  (1280 + 64 * (j))
#define XB_XGEN(j)  (2304 + 64 * (j))
#define XB_TOP      3328
#define XB_TOPGEN   3392
#define XCD_BAR_WORDS 3456
#define XB_SPIN_CAP (1u << 18)
#define LAS __attribute__((address_space(3)))
__device__ __forceinline__ unsigned xb_ld(unsigned* p)              { return __hip_atomic_load(p, __ATOMIC_RELAXED, __HIP_MEMORY_SCOPE_AGENT); }
__device__ __forceinline__ unsigned xb_add(unsigned* p, unsigned v) { return __hip_atomic_fetch_add(p, v, __ATOMIC_RELAXED, __HIP_MEMORY_SCOPE_AGENT); }
__device__ __forceinline__ unsigned xb_xcc_id() { return (unsigned)__builtin_amdgcn_s_getreg((3 << 11) | 20) & 0xFu; }
#define XB_SPIN(cond, bar) do { unsigned _sp = 0; while (cond) { __builtin_amdgcn_s_sleep(1); \
    if ((++_sp & 255u) == 0u) { if (xb_ld(&(bar)[XB_TMO])) break; if (_sp > XB_SPIN_CAP) { atomicAdd(&(bar)[XB_TMO], 1u); break; } } } } while (0)
struct XcdBarrier { unsigned* bar; unsigned x; volatile LAS unsigned* st; };
__device__ __forceinline__ XcdBarrier xcd_barrier_post(unsigned* bar, volatile LAS unsigned* st) {
  XcdBarrier b; b.bar = bar; b.x = xb_xcc_id(); b.st = st;
  if (threadIdx.x == 0) (void)xb_add(&bar[XB_XCNT(b.x)], 1u);
  return b;
}
__device__ __forceinline__ void xcd_barrier_complete(unsigned* bar, unsigned x, unsigned& nloc, unsigned& nx) {
  const unsigned G = gridDim.x * gridDim.y * gridDim.z;
  unsigned sum, cnt, mine, sp = 0u;
  for (;;) {
    sum = 0u; cnt = 0u; mine = 0u;
#pragma unroll
    for (unsigned j = 0; j < 16; ++j) { const unsigned c = xb_ld(&bar[XB_XCNT(j)]); sum += c; cnt += (c > 0u) ? 1u : 0u; mine = (j == x) ? c : mine; }
    if (sum == G) break;
    __builtin_amdgcn_s_sleep(1);
    if ((++sp & 255u) == 0u) { if (xb_ld(&bar[XB_TMO])) break; if (sp > XB_SPIN_CAP) { atomicAdd(&bar[XB_TMO], 1u); break; } }
  }
  nloc = mine > 0u ? mine : 1u; nx = cnt > 0u ? cnt : 1u;
}
__device__ __forceinline__ void xcd_barrier(const XcdBarrier& b) {
  asm volatile("s_waitcnt vmcnt(0)" ::: "memory");
  __syncthreads();
  if (threadIdx.x == 0) {
    unsigned* bar = b.bar;
    __builtin_amdgcn_s_waitcnt(0);
    unsigned nloc = b.st[0], nx = b.st[1];
    if (nloc == 0u) { xcd_barrier_complete(bar, b.x, nloc, nx); b.st[0] = nloc; b.st[1] = nx; }
    const unsigned old = xb_add(&bar[XB_XSUB(b.x)], 1u);
    const unsigned gen = old / nloc;
    if (old + 1u == (gen + 1u) * nloc) {
      __builtin_amdgcn_fence(__ATOMIC_RELEASE, "agent");
      asm volatile("s_waitcnt vmcnt(0)" ::: "memory");
      const unsigned og = xb_add(&bar[XB_TOP], 1u);
      const unsigned tg = og / nx;
      if (og + 1u == (tg + 1u) * nx) xb_add(&bar[XB_TOPGEN], 1u);
      else XB_SPIN(xb_ld(&bar[XB_TOPGEN]) == tg, bar);
      __builtin_amdgcn_fence(__ATOMIC_ACQUIRE, "agent");
      xb_add(&bar[XB_XGEN(b.x)], 1u);
      asm volatile("s_waitcnt vmcnt(0)" ::: "memory");
    } else {
      XB_SPIN(xb_ld(&bar[XB_XGEN(b.x)]) == gen, bar);
      __builtin_amdgcn_fence(__ATOMIC_ACQUIRE, "agent");
      asm volatile("s_waitcnt vmcnt(0)" ::: "memory");
    }
  }
  __syncthreads();
}

__global__ void __launch_bounds__(256, 2) mega(Params p_arg, int ph_lo, int ph_hi, int coop) {
  __shared__ __attribute__((aligned(16))) unsigned char smem[SMEM_BYTES];
  __shared__ u32x4 xb_words;
  cg::grid_group grid = cg::this_grid();
  if (threadIdx.x == 0) xb_words = u32x4{0u, 0u, 0u, 0u};
  __syncthreads();
  if (coop) (void)xcd_barrier_post(((PP)__builtin_amdgcn_kernarg_segment_ptr())->bar, (volatile LAS unsigned*)&xb_words);
  for (int ph = ph_lo; ph < ph_hi; ph++) {
    const int reps = (int)((PROBE_MASK >> ph) & 1u) + 1;
    for (int rep = 0; rep < reps; rep++) {
      PP p = (PP)__builtin_amdgcn_kernarg_segment_ptr();
      asm volatile("" : "+s"(p));
      if (ph == 0) {
        phase_prologue(p, smem);
      } else {
        const int layer = (ph - 1) / 6, k = (ph - 1) % 6;
        switch (k) {
          case 0: phase_inproj(p, layer, smem); break;
          case 1: phase_mixer(p, layer, smem); break;
          case 2: phase_outproj(p, layer, smem); break;
          case 3: phase_ln1(p, layer); break;
          case 4: phase_peerq(p, layer, smem); break;
          default: phase_gather(p, layer, smem); break;
        }
      }
      if (coop == 1 && (rep + 1 < reps || ph + 1 < ph_hi)) {
        XcdBarrier xb; xb.bar = p->bar; xb.x = xb_xcc_id(); xb.st = (volatile LAS unsigned*)&xb_words;
        xcd_barrier(xb);
      }
      if (coop == 2) grid.sync();
    }
  }
}

extern "C" void kernel_launch(void* const* d_in, const int* in_sizes, int n_in, void* d_out, int out_size, void* d_ws,
                              size_t ws_size, hipStream_t stream) {
  Params p{};
  p.x_prompt = (const float*)d_in[0]; p.x_sample = (const float*)d_in[1];
  p.cache_swa_k = (const float*)d_in[2]; p.cache_swa_v = (const float*)d_in[3];
  p.cache_mem_k = (const float*)d_in[4]; p.cache_mem_v = (const float*)d_in[5];
  p.mem_prompt = (const float*)d_in[6];
  p.a_w_in = (const float*)d_in[7]; p.a_sink = (const float*)d_in[8]; p.b_w_in = (const float*)d_in[9];
  p.b_v_ln_g = (const float*)d_in[10]; p.b_v_ln_b = (const float*)d_in[11]; p.b_w_s = (const float*)d_in[12];
  p.b_b_s = (const float*)d_in[13]; p.w_mem_kv = (const float*)d_in[14]; p.w_out = (const float*)d_in[15];
  p.ln1_g = (const float*)d_in[16]; p.ln1_b = (const float*)d_in[17]; p.ln2_g = (const float*)d_in[18]; p.ln2_b = (const float*)d_in[19];
  p.peer_w_q = (const float*)d_in[20]; p.peer_b_q = (const float*)d_in[21]; p.peer_subkeys = (const float*)d_in[22];
  p.peer_u = (const float*)d_in[23]; p.peer_v = (const float*)d_in[24];
  float* o = (float*)d_out;
  p.y_out = o;                       o += (size_t)T_ALL * 1024;
  p.swa_k_prompt = o;                o += 131072;
  p.swa_v_prompt = o;                o += 131072;
  p.swa_k_sample = o;                o += 262144;
  p.swa_v_sample = o;                o += 262144;
  p.sg_v_sample = o;                 o += 786432;
  p.mem_k_prompt = o;                o += 524288;
  p.mem_v_prompt = o;
  unsigned char* wsb = (unsigned char*)d_ws;
  size_t off = 0;
  auto carve = [&](size_t bytes) { void* r = wsb + off; off += (bytes + 255) & ~(size_t)255; return r; };
  p.wT_a_in = (u16*)carve((size_t)2 * 1536 * 1024 * 2);
  p.wT_b_in = (u16*)carve((size_t)2 * 1792 * 1024 * 2);
  p.wT_memkv = (u16*)carve((size_t)4 * 512 * 1024 * 2);
  p.wT_out = (u16*)carve((size_t)4 * 1024 * 1024 * 2);
  p.wT_pq = (u16*)carve((size_t)4 * 2048 * 1024 * 2);
  p.subk = (u16*)carve((size_t)4 * 8 * 2 * 128 * 128 * 2);
  p.ub = (unsigned char*)carve((size_t)4 * 16384 * 1280);
  p.vb = p.ub;
  p.memb = (u16*)carve((size_t)512 * 1024 * 2);
  p.xb = (u16*)carve((size_t)T_ALL * 1024 * 2);
  p.z = (u16*)carve((size_t)T_ALL * ZLD * 2);
  p.mix = (u16*)carve((size_t)T_ALL * 1024 * 2);
  p.mkvp = (u16*)carve((size_t)4 * 2 * 512 * 256 * 2);
  p.xf = (float*)carve((size_t)T_ALL * 1024 * 4);
  p.pre = (float*)carve((size_t)T_ALL * 1024 * 4);
  p.ropecs = (float*)carve((size_t)8196 * 8 * 2 * 4);
  p.topk = (uint32_t*)carve((size_t)T_ALL * 16 * 16 * 4);
  p.bar = (unsigned*)carve((size_t)XCD_BAR_WORDS * 4);
  if (off > ws_size) { fprintf(stderr, "workspace too small: need %zu have %zu\n", off, ws_size); return; }

  static int grid_blocks = 0;
  if (!grid_blocks) {
    int dev = 0, cus = 0, per_cu = 0;
    (void)hipGetDevice(&dev);
    (void)hipDeviceGetAttribute(&cus, hipDeviceAttributeMultiprocessorCount, dev);
    (void)hipOccupancyMaxActiveBlocksPerMultiprocessor(&per_cu, mega, 256, 0);
    if (per_cu < 1) per_cu = 1;
    if (per_cu > 2) per_cu = 2;
    grid_blocks = cus * per_cu;
  }
#if MK_MULTI
  for (int ph = 0; ph < N_PHASES; ph++) mega<<<dim3(grid_blocks), dim3(256), 0, stream>>>(p, ph, ph + 1, 0);
#else
  (void)hipMemsetAsync(p.bar, 0, (size_t)XCD_BAR_WORDS * 4, stream);
  int lo = 0, hi = N_PHASES, coop = 1;
  void* args[] = {&p, &lo, &hi, &coop};
  hipError_t e = hipLaunchCooperativeKernel((void*)mega, dim3(grid_blocks), dim3(256), args, 0, stream);
  if (e != hipSuccess) fprintf(stderr, "cooperative launch failed: %s (grid %d)\n", hipGetErrorString(e), grid_blocks);
#endif
}
```

```cpp
#include <hip/hip_runtime.h>
#include <hip/hip_cooperative_groups.h>
#include <stdint.h>
#include <cstdio>
namespace cg = cooperative_groups;

#ifndef MK_MULTI
#define MK_MULTI 0
#endif

typedef unsigned short u16;
typedef __attribute__((ext_vector_type(8))) short bf16x8;
typedef __attribute__((ext_vector_type(4))) float f32x4;
typedef __attribute__((ext_vector_type(2))) float f32x2;
typedef __attribute__((ext_vector_type(4))) unsigned int u32x4;
typedef __attribute__((ext_vector_type(2))) unsigned int u32x2;
typedef __attribute__((ext_vector_type(6))) unsigned int u32x6;
typedef __attribute__((ext_vector_type(16))) float f32x16;
typedef __attribute__((ext_vector_type(32))) float f32x32;

#define T_P 16384
#define T_ALL 16896
#define ZLD 1792
#define SMEM_BYTES 73728
#define DN_ALPHA_F 1.6817928305074292f
#define LN_EPS_F 1e-5f
#define N_PHASES 25
#define PEER_SU 48.0f
#define PEER_SV 12.0f
#ifndef PROBE_MASK
#define PROBE_MASK 0u
#endif

struct Params {
  const float *x_prompt, *x_sample, *cache_swa_k, *cache_swa_v, *cache_mem_k, *cache_mem_v, *mem_prompt;
  const float *a_w_in, *a_sink, *b_w_in, *b_v_ln_g, *b_v_ln_b, *b_w_s, *b_b_s, *w_mem_kv, *w_out;
  const float *ln1_g, *ln1_b, *ln2_g, *ln2_b, *peer_w_q, *peer_b_q, *peer_subkeys, *peer_u, *peer_v;
  float *y_out, *swa_k_prompt, *swa_v_prompt, *swa_k_sample, *swa_v_sample, *sg_v_sample, *mem_k_prompt, *mem_v_prompt;
  u16 *wT_a_in, *wT_b_in, *wT_memkv, *wT_out, *wT_pq, *subk, *memb, *xb, *z, *mix, *mkvp;
  unsigned char *ub, *vb;
  float *ropecs;
  u16 *preb;
  uint32_t *topk;
  unsigned *bar;
};

typedef const __attribute__((address_space(4))) Params* PP;

__constant__ double c_rope_inv[8] = {1.0, 0.19392274474868576, 0.03760603093086393, 0.007292664737217109,
  0.001414213562373095, 0.0002742481756762073, 5.318295896944988e-05, 1.031338537721246e-05};
__constant__ unsigned char c_cand[64] = {
  0x00,0x01,0x02,0x03,0x04,0x05,0x06,0x07,0x08,0x09,0x0a,0x0b,0x0c,0x0d,0x0e,0x0f,0x10,0x11,0x12,0x13,0x14,0x15,0x16,0x17,
  0x20,0x21,0x22,0x23,0x24,0x30,0x31,0x32,0x33,0x40,0x41,0x42,0x50,0x51,0x60,0x61,0x70,0x71,0x80,0x90,0xa0,0xb0,0xc0,0xd0,
  0xe0,0xf0,0,0,0,0,0,0,0,0,0,0,0,0,0,0};

__device__ __forceinline__ int tid_opaque() { int t = threadIdx.x; asm volatile("" : "+v"(t)); return t; }
__device__ __forceinline__ int bid_opaque() { int b = blockIdx.x; asm volatile("" : "+s"(b)); return b; }
__device__ __forceinline__ u32x4 zero4() { uint32_t z = 0; asm volatile("" : "+v"(z)); return u32x4{z, z, z, z}; }
__device__ __forceinline__ uint32_t pack_bf16(float a, float b) {
  uint32_t ua = __float_as_uint(a), ub = __float_as_uint(b);
  ua += 0x7FFFu + ((ua >> 16) & 1u);
  ub += 0x7FFFu + ((ub >> 16) & 1u);
  return (ua >> 16) | (ub & 0xFFFF0000u);
}
__device__ __forceinline__ u16 f2bf(float a) {
  uint32_t ua = __float_as_uint(a);
  ua += 0x7FFFu + ((ua >> 16) & 1u);
  return (u16)(ua >> 16);
}
__device__ __forceinline__ float bf2f(u16 h) { return __uint_as_float(((uint32_t)h) << 16); }
__device__ __forceinline__ float bflo(uint32_t w) { return __uint_as_float(w << 16); }
__device__ __forceinline__ float bfhi(uint32_t w) { return __uint_as_float(w & 0xFFFF0000u); }
__device__ __forceinline__ float gelu_exact(float x) { return 0.5f * x * (1.0f + erff(x * 0.70710678118654752f)); }
__device__ __forceinline__ u32x4 cvt8(f32x4 a, f32x4 b) {
  u32x4 o; o.x = pack_bf16(a.x, a.y); o.y = pack_bf16(a.z, a.w); o.z = pack_bf16(b.x, b.y); o.w = pack_bf16(b.z, b.w); return o;
}
__device__ __forceinline__ bf16x8 as_frag(u32x4 v) { union { u32x4 u; bf16x8 f; } c; c.u = v; return c.f; }
__device__ __forceinline__ float wave_sum(float v) {
#pragma unroll
  for (int o = 32; o >= 1; o >>= 1) v += __shfl_xor(v, o);
  return v;
}

__device__ __forceinline__ void stage_half(const u16* __restrict__ base, int ld, unsigned char* dst, int tid) {
#pragma unroll
  for (int i = 0; i < 4; i++) {
    const int b = tid * 16 + i * 4096;
    const int st = b >> 10, sb = b & 1023, swz = sb ^ (((sb >> 9) & 1) << 5);
    const int R = (st >> 1) * 16 + (swz >> 6), C = (st & 1) * 32 + ((swz & 63) >> 1);
    __builtin_amdgcn_global_load_lds((const unsigned*)(base + (size_t)R * ld + C), (unsigned*)(dst + b), 16, 0, 0);
  }
}
#define WAIT_VM(n) asm volatile("s_waitcnt vmcnt(" #n ")" ::: "memory")

__device__ __forceinline__ void gemm128(const u16* __restrict__ A, int lda, const u16* __restrict__ Bt, int ldb, int K,
                                        u16* lds, f32x4 (&acc)[4][4]) {
  const int tid = tid_opaque(), lane = tid & 63, w = tid >> 6;
  const int wm = w >> 1, wn = w & 1, fr = lane & 15, fq = lane >> 4;
#pragma unroll
  for (int i = 0; i < 4; i++)
#pragma unroll
    for (int j = 0; j < 4; j++) acc[i][j] = f32x4{0.f, 0.f, 0.f, 0.f};
  unsigned char* L = (unsigned char*)lds;
  const int nk = K >> 6;
  stage_half(A, lda, L, tid);
  stage_half(Bt, ldb, L + 16384, tid);
  stage_half(A + 64, lda, L + 32768, tid);
  stage_half(Bt + 64, ldb, L + 49152, tid);
  const int laneoff = fr * 64 + ((fq ^ ((fr >> 3) << 1)) << 4);
  const unsigned char* rA = L + wm * 8192 + laneoff;
  const unsigned char* rB = L + 16384 + wn * 8192 + laneoff;
  for (int kt = 0; kt < nk; kt++) {
    const int cur = (kt & 1) * 32768;
    if (kt + 1 < nk) WAIT_VM(8); else WAIT_VM(0);
    __builtin_amdgcn_s_barrier();
    asm volatile("" ::: "memory");
#pragma unroll
    for (int ks = 0; ks < 2; ks++) {
      bf16x8 af[4], bfr[4];
#pragma unroll
      for (int i = 0; i < 4; i++) af[i] = *(const bf16x8*)(rA + cur + (i * 2 + ks) * 1024);
#pragma unroll
      for (int j = 0; j < 4; j++) bfr[j] = *(const bf16x8*)(rB + cur + (j * 2 + ks) * 1024);
#pragma unroll
      for (int i = 0; i < 4; i++)
#pragma unroll
        for (int j = 0; j < 4; j++) acc[i][j] = __builtin_amdgcn_mfma_f32_16x16x32_bf16(af[i], bfr[j], acc[i][j], 0, 0, 0);
    }
    asm volatile("s_waitcnt lgkmcnt(0)" ::: "memory");
    __builtin_amdgcn_s_barrier();
    asm volatile("" ::: "memory");
    if (kt + 2 < nk) {
      stage_half(A + (kt + 2) * 64, lda, L + cur, tid);
      stage_half(Bt + (kt + 2) * 64, ldb, L + cur + 16384, tid);
    }
  }
  __syncthreads();
}

__device__ __forceinline__ void transpose_tile(const float* __restrict__ src, u16* __restrict__ dst, int K, int N, int k0, int n0, float* tl) {
  const int tid = tid_opaque();
#pragma unroll
  for (int i = 0; i < 4; i++) {
    int r = (tid >> 4) + i * 16, c = (tid & 15) * 4;
    f32x4 v = *(const f32x4*)(src + (size_t)(k0 + r) * N + n0 + c);
    tl[r * 65 + c] = v.x; tl[r * 65 + c + 1] = v.y; tl[r * 65 + c + 2] = v.z; tl[r * 65 + c + 3] = v.w;
  }
  __syncthreads();
  const int n = tid >> 2, kc = (tid & 3) * 16;
  uint32_t o[8];
#pragma unroll
  for (int e = 0; e < 8; e++) o[e] = pack_bf16(tl[(kc + 2 * e) * 65 + n], tl[(kc + 2 * e + 1) * 65 + n]);
  u32x4* d = (u32x4*)(dst + (size_t)(n0 + n) * K + k0 + kc);
  d[0] = u32x4{o[0], o[1], o[2], o[3]};
  d[1] = u32x4{o[4], o[5], o[6], o[7]};
  __syncthreads();
}

__device__ __forceinline__ void convert_span(const float* __restrict__ s, u16* __restrict__ d, float* __restrict__ fcopy, size_t n8) {
  const size_t stride = (size_t)gridDim.x * 256;
  for (size_t g0 = (size_t)bid_opaque() * 256 + tid_opaque(); g0 < n8; g0 += stride * 4) {
    f32x4 a[4], b[4];
#pragma unroll
    for (int u = 0; u < 4; u++) {
      const size_t g = g0 + u * stride;
      if (g < n8) { a[u] = ((const f32x4*)s)[2 * g]; b[u] = ((const f32x4*)s)[2 * g + 1]; }
    }
#pragma unroll
    for (int u = 0; u < 4; u++) {
      const size_t g = g0 + u * stride;
      if (g < n8) {
        ((u32x4*)d)[g] = cvt8(a[u], b[u]);
        if (fcopy) { ((f32x4*)fcopy)[2 * g] = a[u]; ((f32x4*)fcopy)[2 * g + 1] = b[u]; }
      }
    }
  }
}
__device__ __forceinline__ void convert_span_fp6(const float* __restrict__ s, unsigned char* __restrict__ d, size_t gbeg, size_t n32, float sc) {
  const size_t stride = (size_t)gridDim.x * 256;
  for (size_t g0 = gbeg + (size_t)bid_opaque() * 256 + tid_opaque(); g0 < n32; g0 += stride * 2) {
    f32x4 a[2][8];
#pragma unroll
    for (int u = 0; u < 2; u++) {
      const size_t g = g0 + u * stride;
      if (g < n32) {
#pragma unroll
        for (int q = 0; q < 8; q++) a[u][q] = __builtin_nontemporal_load(((const f32x4*)s) + 8 * g + q);
      }
    }
#pragma unroll
    for (int u = 0; u < 2; u++) {
      const size_t g = g0 + u * stride;
      if (g < n32) {
        f32x16 lo, hi;
#pragma unroll
        for (int q = 0; q < 4; q++)
#pragma unroll
          for (int e = 0; e < 4; e++) {
            const int idx = q * 4 + e;
            lo[idx] = a[u][idx >> 1][(idx & 1) * 2] * sc; hi[idx] = a[u][idx >> 1][(idx & 1) * 2 + 1] * sc;
          }
        const u32x6 pk = __builtin_amdgcn_cvt_scalef32_2xpk16_fp6_f32(lo, hi, 1.0f);
        u32x2* dp = (u32x2*)(d + (g >> 5) * 1280 + (g & 31) * 24);
        dp[0] = u32x2{pk[0], pk[1]}; dp[1] = u32x2{pk[2], pk[3]}; dp[2] = u32x2{pk[4], pk[5]};
      }
    }
  }
}

__device__ __forceinline__ void convert_span_fp4(const float* __restrict__ s, unsigned char* __restrict__ d, size_t gbeg, size_t n32, float sc) {
  const size_t stride = (size_t)gridDim.x * 256;
  for (size_t g0 = gbeg + (size_t)bid_opaque() * 256 + tid_opaque(); g0 < n32; g0 += stride * 2) {
    f32x4 a[2][8];
#pragma unroll
    for (int u = 0; u < 2; u++) {
      const size_t g = g0 + u * stride;
      if (g < n32) {
#pragma unroll
        for (int q = 0; q < 8; q++) a[u][q] = __builtin_nontemporal_load(((const f32x4*)s) + 8 * g + q);
      }
    }
#pragma unroll
    for (int u = 0; u < 2; u++) {
      const size_t g = g0 + u * stride;
      if (g < n32) {
        u32x4 o;
#pragma unroll
        for (int wd = 0; wd < 4; wd++) {
          unsigned wv = 0;
          wv = __builtin_amdgcn_cvt_scalef32_pk_fp4_f32(wv, a[u][2 * wd].x * sc, a[u][2 * wd].y * sc, 1.0f, 0);
          wv = __builtin_amdgcn_cvt_scalef32_pk_fp4_f32(wv, a[u][2 * wd].z * sc, a[u][2 * wd].w * sc, 1.0f, 1);
          wv = __builtin_amdgcn_cvt_scalef32_pk_fp4_f32(wv, a[u][2 * wd + 1].x * sc, a[u][2 * wd + 1].y * sc, 1.0f, 2);
          wv = __builtin_amdgcn_cvt_scalef32_pk_fp4_f32(wv, a[u][2 * wd + 1].z * sc, a[u][2 * wd + 1].w * sc, 1.0f, 3);
          o[wd] = wv;
        }
        *(u32x4*)(d + (g >> 5) * 1280 + 768 + (g & 31) * 16) = o;
      }
    }
  }
}

__device__ __forceinline__ int xcd_tile(int t, int ntiles) { return (t & 7) * (ntiles >> 3) + (t >> 3); }

__device__ __forceinline__ void convert_tables_part(PP p, int layer, int part) {
  const size_t lo = part == 0 ? 0 : (part == 1 ? 174763 : 349526), hi = part == 0 ? 174763 : (part == 1 ? 349526 : 524288);
  const size_t g0 = (size_t)layer * 524288 + lo;
  convert_span_fp6(p->peer_u, p->ub, g0, g0 + (hi - lo), PEER_SU);
  convert_span_fp4(p->peer_v, p->ub, g0, g0 + (hi - lo), PEER_SV);
}

__device__ __forceinline__ void phase_prologue(PP p, unsigned char* smem) {
  float* tl = (float*)smem;
  for (int t = bid_opaque(); t < 5248; t += gridDim.x) {
    const float* src; u16* dst; int N, tt;
    if (t < 768) { tt = t; N = 1536; src = p->a_w_in; dst = p->wT_a_in; }
    else if (t < 1664) { tt = t - 768; N = 1792; src = p->b_w_in; dst = p->wT_b_in; }
    else if (t < 2176) { tt = t - 1664; N = 512; src = p->w_mem_kv; dst = p->wT_memkv; }
    else if (t < 3200) { tt = t - 2176; N = 1024; src = p->w_out; dst = p->wT_out; }
    else { tt = t - 3200; N = 2048; src = p->peer_w_q; dst = p->wT_pq; }
    const int ntn = N >> 6, per = 16 * ntn;
    const int mat = tt / per, r = tt % per, kt = r / ntn, nt = r % ntn;
    transpose_tile(src + (size_t)mat * 1024 * N, dst + (size_t)mat * 1024 * N, 1024, N, kt * 64, nt * 64, tl);
  }
  convert_span(p->peer_subkeys, p->subk, nullptr, 131072);
  convert_span(p->mem_prompt, p->memb, nullptr, 65536);
  convert_span(p->x_prompt, p->xb, nullptr, 2097152);
  convert_span(p->x_sample, p->xb + (size_t)T_P * 1024, nullptr, 65536);
  for (int idx = bid_opaque() * 256 + tid_opaque(); idx < 8196 * 8; idx += gridDim.x * 256) {
    const int pos = idx >> 3, d = idx & 7;
    const double inv = c_rope_inv[d];
    double ang = (double)pos * inv;
    double n = rint(ang * 0.15915494309189535);
    double r = ang - n * 6.283185307179586476925;
    double r2 = r * r, ts = r, tc = 1.0, ss = r, cc = 1.0;
    for (int k = 0; k < 14; k++) {
      tc = -tc * r2 / (double)((2 * k + 1) * (2 * k + 2));
      ts = -ts * r2 / (double)((2 * k + 2) * (2 * k + 3));
      cc += tc; ss += ts;
    }
    p->ropecs[2 * idx] = (float)cc;
    p->ropecs[2 * idx + 1] = (float)ss;
  }
}

__device__ __forceinline__ void phase_inproj(PP p, int layer, unsigned char* smem) {
  const int jl = layer >> 1;
  const bool isA = !(layer & 1);
  const int NIN = isA ? 1536 : 1792, ntn = NIN >> 7;
  const u16* W = isA ? p->wT_a_in + (size_t)jl * 1536 * 1024 : p->wT_b_in + (size_t)jl * 1792 * 1024;
  const int ntiles = 132 * ntn, extra = (layer == 0) ? 64 : 0;
  const int tid = tid_opaque(), lane = tid & 63, w = tid >> 6, wm = w >> 1, wn = w & 1, quad = lane >> 4, lc = lane & 15;
  for (int t = bid_opaque(); t < ntiles + extra; t += gridDim.x) {
    f32x4 acc[4][4];
    if (t < ntiles) {
      const int tx = xcd_tile(t, ntiles);
      const int tm = tx / ntn, tn = tx % ntn;
      gemm128(p->xb + (size_t)tm * 128 * 1024, 1024, W + (size_t)tn * 128 * 1024, 1024, 1024, (u16*)smem, acc);
      const int rb = tm * 128 + wm * 64, cb = tn * 128 + wn * 64;
      u16* Cs = (u16*)smem;
      if (isA && tn < 8) {
        f32x2 cs[4][4];
#pragma unroll
        for (int i = 0; i < 4; i++)
#pragma unroll
          for (int r = 0; r < 4; r++) {
            const int row = rb + i * 16 + quad * 4 + r;
            const int pos = row < T_P ? (row & 8191) : 8192 + ((row - T_P) & 3);
            cs[i][r] = *(const f32x2*)(p->ropecs + (size_t)(pos * 8 + (lc & 7)) * 2);
          }
#pragma unroll
        for (int i = 0; i < 4; i++)
#pragma unroll
          for (int r = 0; r < 4; r++) {
            const float v = acc[i][0][r];
            const float partner = __shfl_xor(v, 8);
            acc[i][0][r] = (lc < 8) ? (v * cs[i][r].x - partner * cs[i][r].y) : (v * cs[i][r].x + partner * cs[i][r].y);
          }
      }
      if (!isA && tn < 12) {
#pragma unroll
        for (int i = 0; i < 4; i++)
#pragma unroll
          for (int j = 0; j < 4; j++)
#pragma unroll
            for (int r = 0; r < 4; r++) acc[i][j][r] = gelu_exact(acc[i][j][r]);
      }
#pragma unroll
      for (int i = 0; i < 4; i++)
#pragma unroll
        for (int j = 0; j < 4; j++)
#pragma unroll
          for (int r = 0; r < 4; r++) Cs[(wm * 64 + i * 16 + quad * 4 + r) * 136 + wn * 64 + j * 16 + lc] = f2bf(acc[i][j][r]);
      if (isA && tn >= 6 && tn < 10) {
        float* okp = (tn < 8) ? p->swa_k_prompt : p->swa_v_prompt;
        float* oks = (tn < 8) ? p->swa_k_sample : p->swa_v_sample;
        const int cko = (tn < 8) ? 768 : 1024;
#pragma unroll
        for (int i = 0; i < 4; i++)
#pragma unroll
          for (int r = 0; r < 4; r++) {
            const int row = rb + i * 16 + quad * 4 + r;
            float* dst = nullptr;
            if (row < T_P) {
              const int b = row >> 13, s2 = row & 8191;
              if (s2 >= 8064) dst = okp + ((size_t)(jl * 2 + b) * 128 + (s2 - 8064)) * 256;
            } else {
              dst = oks + ((size_t)jl * 512 + (row - T_P)) * 256;
            }
            if (dst) {
#pragma unroll
              for (int j = 0; j < 4; j++) dst[cb + j * 16 + lc - cko] = acc[i][j][r];
            }
          }
      }
      __syncthreads();
#pragma unroll
      for (int it = 0; it < 8; it++) {
        const int row = it * 16 + (tid >> 4), ch = tid & 15;
        *(u32x4*)(p->z + (size_t)(tm * 128 + row) * ZLD + tn * 128 + ch * 8) = *(const u32x4*)(Cs + row * 136 + ch * 8);
      }
      __syncthreads();
    } else {
      const int t2 = t - ntiles, l = t2 >> 4, tm = (t2 >> 2) & 3, tn = t2 & 3;
      gemm128(p->memb + (size_t)tm * 128 * 1024, 1024, p->wT_memkv + ((size_t)l * 512 + tn * 128) * 1024, 1024, 1024, (u16*)smem, acc);
      const int rb = tm * 128 + wm * 64, cb = tn * 128 + wn * 64;
#pragma unroll
      for (int i = 0; i < 4; i++)
#pragma unroll
        for (int j = 0; j < 4; j++)
#pragma unroll
          for (int r = 0; r < 4; r++) {
            const int row = rb + i * 16 + quad * 4 + r, col = cb + j * 16 + lc;
            const float v = acc[i][j][r];
            const int kv = col >> 8, c2 = col & 255;
            float* o = kv ? p->mem_v_prompt : p->mem_k_prompt;
            o[((size_t)l * 512 + row) * 256 + c2] = v;
            p->mkvp[((size_t)(l * 2 + kv) * 512 + row) * 256 + c2] = f2bf(v);
          }
    }
  }
  convert_tables_part(p, layer, 0);
}

template <int NK, bool SINK, int NSUB, class FK, class FV, class FQ, class FM, class FS, class FO>
__device__ __forceinline__ void attn_core(u16* lds, int nrows, FK loadK, FV loadV, FQ loadQ, FM allowed, FS sinkf, FO outp) {
  const int tid = tid_opaque(), lane = tid & 63, w = tid >> 6, quad = lane >> 4, lc = lane & 15;
  u16* Ks = lds;
  u16* Vt = lds + 256 * 72;
  {
    constexpr int NIT = NK * 8 / 256;
    u32x4 kreg[NIT], vreg[NIT];
#pragma unroll
    for (int it = 0; it < NIT; it++) {
      const int c = tid + it * 256, kk = c >> 3, ch = c & 7;
      kreg[it] = loadK(kk, ch);
      vreg[it] = loadV(kk, ch);
    }
#pragma unroll
    for (int it = 0; it < NIT; it++) {
      const int c = tid + it * 256, kk = c >> 3, ch = c & 7;
      *(u32x4*)(Ks + kk * 72 + ch * 8) = kreg[it];
      const u32x4 vv = vreg[it];
      u16* vd = Vt + (ch * 8) * 264 + kk;
      vd[0 * 264] = (u16)(vv.x & 0xFFFF); vd[1 * 264] = (u16)(vv.x >> 16);
      vd[2 * 264] = (u16)(vv.y & 0xFFFF); vd[3 * 264] = (u16)(vv.y >> 16);
      vd[4 * 264] = (u16)(vv.z & 0xFFFF); vd[5 * 264] = (u16)(vv.z >> 16);
      vd[6 * 264] = (u16)(vv.w & 0xFFFF); vd[7 * 264] = (u16)(vv.w >> 16);
    }
  }
  __syncthreads();
  const bool active = (w * 16 < nrows);
  constexpr int NT = NK / 16;
  if (active) {
    const int row = w * 16 + lc;
    bf16x8 qn0 = as_frag(loadQ(0, row, quad * 8)), qn1 = as_frag(loadQ(0, row, 32 + quad * 8));
#pragma unroll 1
    for (int sub = 0; sub < NSUB; sub++) {
      bf16x8 qf[1][2];
      qf[0][0] = qn0; qf[0][1] = qn1;
      if (sub + 1 < NSUB) { qn0 = as_frag(loadQ(sub + 1, row, quad * 8)); qn1 = as_frag(loadQ(sub + 1, row, 32 + quad * 8)); }
      f32x4 s[NT];
#pragma unroll
      for (int nt = 0; nt < NT; nt++) {
        s[nt] = f32x4{0.f, 0.f, 0.f, 0.f};
#pragma unroll
        for (int ks = 0; ks < 2; ks++) {
          const bf16x8 kf = *(const bf16x8*)(Ks + (nt * 16 + lc) * 72 + ks * 32 + quad * 8);
          s[nt] = __builtin_amdgcn_mfma_f32_16x16x32_bf16(kf, qf[0][ks], s[nt], 0, 0, 0);
        }
      }
      __builtin_amdgcn_sched_barrier(0);
      const float sk = SINK ? sinkf(sub, row) : -3.0e38f;
      float m = sk;
#pragma unroll
      for (int nt = 0; nt < NT; nt++)
#pragma unroll
        for (int r = 0; r < 4; r++) {
          const float v = allowed(sub, row, nt * 16 + quad * 4 + r) ? s[nt][r] * 0.125f : -1.0e30f;
          s[nt][r] = v;
          m = fmaxf(m, v);
        }
      m = fmaxf(m, __shfl_xor(m, 16)); m = fmaxf(m, __shfl_xor(m, 32));
      float sum = 0.f;
#pragma unroll
      for (int nt = 0; nt < NT; nt++)
#pragma unroll
        for (int r = 0; r < 4; r++) { const float e = __expf(s[nt][r] - m); s[nt][r] = e; sum += e; }
      sum += __shfl_xor(sum, 16); sum += __shfl_xor(sum, 32);
      if (SINK) sum += __expf(sk - m);
      const float inv = 1.0f / sum;
      __builtin_amdgcn_sched_barrier(0);
      f32x4 o[4];
#pragma unroll
      for (int dt = 0; dt < 4; dt++) o[dt] = f32x4{0.f, 0.f, 0.f, 0.f};
#pragma unroll
      for (int kk = 0; kk < NT / 2; kk++) {
        u32x4 pp;
        pp.x = pack_bf16(s[2 * kk][0] * inv, s[2 * kk][1] * inv); pp.y = pack_bf16(s[2 * kk][2] * inv, s[2 * kk][3] * inv);
        pp.z = pack_bf16(s[2 * kk + 1][0] * inv, s[2 * kk + 1][1] * inv); pp.w = pack_bf16(s[2 * kk + 1][2] * inv, s[2 * kk + 1][3] * inv);
        const bf16x8 pf = as_frag(pp);
#pragma unroll
        for (int dt = 0; dt < 4; dt++) {
          const u16* vr = Vt + (dt * 16 + lc) * 264 + kk * 32 + quad * 4;
          const u32x2 v0 = *(const u32x2*)vr, v1 = *(const u32x2*)(vr + 16);
          const bf16x8 vf = as_frag(u32x4{v0.x, v0.y, v1.x, v1.y});
          o[dt] = __builtin_amdgcn_mfma_f32_16x16x32_bf16(vf, pf, o[dt], 0, 0, 0);
        }
        __builtin_amdgcn_sched_barrier(0);
      }
      if (row < nrows) {
        u16* op = outp(sub, row);
#pragma unroll
        for (int dt = 0; dt < 4; dt++)
          *(u32x2*)(op + dt * 16 + quad * 4) = u32x2{pack_bf16(o[dt][0], o[dt][1]), pack_bf16(o[dt][2], o[dt][3])};
      }
    }
  }
  __syncthreads();
}

__device__ __forceinline__ u32x4 ld_f32x8_as_bf16(const float* ptr) {
  const f32x4 a = *(const f32x4*)ptr, b = *(const f32x4*)(ptr + 4);
  return cvt8(a, b);
}

__device__ __forceinline__ void sg_prompt_item(PP p, int jl, int item, unsigned char* smem) {
  const int tid = tid_opaque(), lane = tid & 63, w = tid >> 6, quad = lane >> 4, lc = lane & 15;
  float* stats = (float*)smem;
  float* lnp = (float*)(smem + 1024);
  u16* Vt = (u16*)(smem + 2560);
  const int tok0 = (item >> 2) * 128;
  const int g = item & 3;
  for (int bt = 0; bt < 4; bt++) {
    const int srow = w * 32 + bt * 8 + (lane >> 3);
    const u16* zr = p->z + (size_t)(tok0 + srow) * ZLD + 768 + (lane & 7) * 96;
    u32x4 q[12];
#pragma unroll
    for (int i = 0; i < 12; i++) q[i] = *(const u32x4*)(zr + i * 8);
    float sum = 0.f;
#pragma unroll
    for (int i = 0; i < 12; i++)
#pragma unroll
      for (int e = 0; e < 4; e++) sum += bflo(q[i][e]) + bfhi(q[i][e]);
    sum += __shfl_xor(sum, 1); sum += __shfl_xor(sum, 2); sum += __shfl_xor(sum, 4);
    const float mu = sum * (1.0f / 768.0f);
    float sq = 0.f;
#pragma unroll
    for (int i = 0; i < 12; i++)
#pragma unroll
      for (int e = 0; e < 4; e++) { const float d0 = bflo(q[i][e]) - mu, d1 = bfhi(q[i][e]) - mu; sq += d0 * d0 + d1 * d1; }
    sq += __shfl_xor(sq, 1); sq += __shfl_xor(sq, 2); sq += __shfl_xor(sq, 4);
    if ((lane & 7) == 0) { stats[srow * 2] = mu; stats[srow * 2 + 1] = rsqrtf(sq * (1.0f / 768.0f) + LN_EPS_F); }
  }
  if (tid < 192) { lnp[tid * 2] = p->b_v_ln_g[jl * 768 + g * 192 + tid]; lnp[tid * 2 + 1] = p->b_v_ln_b[jl * 768 + g * 192 + tid]; }
  __syncthreads();
  {
    {
      u32x4 q[12];
#pragma unroll
      for (int it = 0; it < 12; it++) {
        const int c2 = tid + it * 256, s2 = c2 / 24, ch = c2 % 24;
        q[it] = *(const u32x4*)(p->z + (size_t)(tok0 + s2) * ZLD + 768 + g * 192 + ch * 8);
      }
#pragma unroll
      for (int it = 0; it < 12; it++) {
        const int c2 = tid + it * 256, s2 = c2 / 24, ch = c2 % 24;
        const float mu = stats[s2 * 2], rs = stats[s2 * 2 + 1];
        const float* lp = lnp + ch * 16;
        u16* vd = Vt + (ch * 8) * 136 + s2;
#pragma unroll
        for (int e = 0; e < 4; e++) {
          vd[(2 * e) * 136] = f2bf((bflo(q[it][e]) - mu) * rs * lp[4 * e] + lp[4 * e + 1]);
          vd[(2 * e + 1) * 136] = f2bf((bfhi(q[it][e]) - mu) * rs * lp[4 * e + 2] + lp[4 * e + 3]);
        }
      }
    }
    __syncthreads();
    const float* wsg = p->b_w_s + (size_t)(jl * 4 + g) * 128 * 128;
    const float* bsg = p->b_b_s + (jl * 4 + g) * 128;
    for (int hh = 0; hh < 2; hh++) {
      f32x4 acc[2][6];
#pragma unroll
      for (int i = 0; i < 2; i++)
#pragma unroll
        for (int jt = 0; jt < 6; jt++) acc[i][jt] = f32x4{0.f, 0.f, 0.f, 0.f};
#pragma unroll
      for (int i = 0; i < 2; i++) {
        const int R = w * 32 + i * 16;
#pragma unroll
        for (int ks = 0; ks < 4; ks++) {
          if (ks * 32 <= R + 15) {
            const int t = R + lc, s0 = ks * 32 + quad * 8;
            const f32x4 a0 = *(const f32x4*)(wsg + t * 128 + s0), a1 = *(const f32x4*)(wsg + t * 128 + s0 + 4);
            float av[8] = {a0.x, a0.y, a0.z, a0.w, a1.x, a1.y, a1.z, a1.w};
#pragma unroll
            for (int e = 0; e < 8; e++) av[e] = (s0 + e <= t) ? av[e] : 0.f;
            u32x4 au; au.x = pack_bf16(av[0], av[1]); au.y = pack_bf16(av[2], av[3]); au.z = pack_bf16(av[4], av[5]); au.w = pack_bf16(av[6], av[7]);
            const bf16x8 a = as_frag(au);
#pragma unroll
            for (int jt = 0; jt < 6; jt++) {
              const bf16x8 b = *(const bf16x8*)(Vt + ((hh * 6 + jt) * 16 + lc) * 136 + ks * 32 + quad * 8);
              acc[i][jt] = __builtin_amdgcn_mfma_f32_16x16x32_bf16(a, b, acc[i][jt], 0, 0, 0);
            }
          }
        }
      }
#pragma unroll
      for (int i = 0; i < 2; i++) {
        float bs[4];
        u16 zu[4][6];
#pragma unroll
        for (int r = 0; r < 4; r++) {
          const int t = w * 32 + i * 16 + quad * 4 + r;
          bs[r] = bsg[t];
          const u16* zp = p->z + (size_t)(tok0 + t) * ZLD + g * 192 + hh * 96;
#pragma unroll
          for (int jt = 0; jt < 6; jt++) zu[r][jt] = zp[jt * 16 + lc];
        }
#pragma unroll
        for (int r = 0; r < 4; r++) {
          const int t = w * 32 + i * 16 + quad * 4 + r;
          u16* mo = p->mix + (size_t)(tok0 + t) * 1024 + g * 192 + hh * 96;
#pragma unroll
          for (int jt = 0; jt < 6; jt++) mo[jt * 16 + lc] = f2bf(bf2f(zu[r][jt]) * (acc[i][jt][r] + bs[r]));
        }
      }
    }
    __syncthreads();
  }
}

__device__ __forceinline__ void sg_sample_item(PP p, int jl, int b, unsigned char* smem) {
  const int tid = tid_opaque(), lane = tid & 63, w = tid >> 6;
  float* vln = (float*)smem;
  {
    const int tok = T_P + b * 4 + w;
    const u16* zr = p->z + (size_t)tok * ZLD + 768;
    float v[12];
#pragma unroll
    for (int i = 0; i < 3; i++) {
      const u32x2 q = *(const u32x2*)(zr + i * 256 + lane * 4);
      v[i * 4 + 0] = bflo(q.x); v[i * 4 + 1] = bfhi(q.x); v[i * 4 + 2] = bflo(q.y); v[i * 4 + 3] = bfhi(q.y);
    }
    float sum = 0.f;
#pragma unroll
    for (int i = 0; i < 12; i++) sum += v[i];
    const float mu = wave_sum(sum) * (1.0f / 768.0f);
    float sq = 0.f;
#pragma unroll
    for (int i = 0; i < 12; i++) { const float d = v[i] - mu; sq += d * d; }
    const float rs = rsqrtf(wave_sum(sq) * (1.0f / 768.0f) + LN_EPS_F);
    float* og = p->sg_v_sample + ((size_t)(jl * 128 + b) * 4 + w) * 768;
    f32x4 lg[3], lb[3];
#pragma unroll
    for (int i = 0; i < 3; i++) { lg[i] = *(const f32x4*)(p->b_v_ln_g + jl * 768 + i * 256 + lane * 4); lb[i] = *(const f32x4*)(p->b_v_ln_b + jl * 768 + i * 256 + lane * 4); }
#pragma unroll
    for (int i = 0; i < 3; i++) {
      f32x4 o;
      o.x = (v[i * 4 + 0] - mu) * rs * lg[i].x + lb[i].x; o.y = (v[i * 4 + 1] - mu) * rs * lg[i].y + lb[i].y;
      o.z = (v[i * 4 + 2] - mu) * rs * lg[i].z + lb[i].z; o.w = (v[i * 4 + 3] - mu) * rs * lg[i].w + lb[i].w;
      *(f32x4*)(vln + w * 768 + i * 256 + lane * 4) = o;
      *(f32x4*)(og + i * 256 + lane * 4) = o;
    }
  }
  __syncthreads();
  {
    float wv[3][10], bsv[3][4], zu[3][4];
#pragma unroll
    for (int k = 0; k < 3; k++) {
      const int c = tid + k * 256, g = c / 192;
      const float* wsg = p->b_w_s + (size_t)(jl * 4 + g) * 128 * 128;
      const float* bsg = p->b_b_s + (jl * 4 + g) * 128;
      int n = 0;
#pragma unroll
      for (int t = 0; t < 4; t++) {
        bsv[k][t] = bsg[t];
        zu[k][t] = bf2f(p->z[(size_t)(T_P + b * 4 + t) * ZLD + c]);
#pragma unroll
        for (int s2 = 0; s2 <= t; s2++) wv[k][n++] = wsg[t * 128 + s2];
      }
    }
#pragma unroll
    for (int k = 0; k < 3; k++) {
      const int c = tid + k * 256;
      int n = 0;
#pragma unroll
      for (int t = 0; t < 4; t++) {
        float sg = bsv[k][t];
#pragma unroll
        for (int s2 = 0; s2 <= t; s2++) sg += wv[k][n++] * vln[s2 * 768 + c];
        p->mix[(size_t)(T_P + b * 4 + t) * 1024 + c] = f2bf(zu[k][t] * sg);
      }
    }
  }
  __syncthreads();
}

__device__ __forceinline__ void mem_prompt_item(PP p, int layer, int it, unsigned char* smem) {
  const int qoff = (layer & 1) ? 1536 : 1280;
  const int mh = it & 3, tp = it >> 2;
  const int tok0 = tp * 128, b = tok0 >> 13;
  const u16* kb = p->mkvp + ((size_t)(layer * 2 + 0) * 512 + b * 256) * 256 + mh * 64;
  const u16* vb = p->mkvp + ((size_t)(layer * 2 + 1) * 512 + b * 256) * 256 + mh * 64;
  const u16* qb = p->z + (size_t)tok0 * ZLD + qoff + mh * 64;
  u16* ob = p->mix + (size_t)tok0 * 1024 + 768 + mh * 64;
  attn_core<256, false, 2>((u16*)smem, 64,
      [&](int kk, int ch) { return *(const u32x4*)(kb + (size_t)kk * 256 + ch * 8); },
      [&](int kk, int ch) { return *(const u32x4*)(vb + (size_t)kk * 256 + ch * 8); },
      [&](int sub, int row, int ko) { return *(const u32x4*)(qb + (size_t)(sub * 64 + row) * ZLD + ko); },
      [&](int, int, int) { return true; },
      [&](int, int) { return 0.f; },
      [&](int sub, int row) { return ob + (size_t)(sub * 64 + row) * 1024; });
}

__device__ __forceinline__ void mem_sample_item(PP p, int layer, int it, unsigned char* smem) {
  const int qoff = (layer & 1) ? 1536 : 1280;
  const int mh = it & 3, b = it >> 2;
  const float* kb = p->cache_mem_k + ((size_t)(layer * 128 + b) * 256) * 256 + mh * 64;
  const float* vb = p->cache_mem_v + ((size_t)(layer * 128 + b) * 256) * 256 + mh * 64;
  const int tok0 = T_P + b * 4;
  const u16* qb = p->z + (size_t)tok0 * ZLD + qoff + mh * 64;
  u16* ob = p->mix + (size_t)tok0 * 1024 + 768 + mh * 64;
  attn_core<256, false, 1>((u16*)smem, 4,
      [&](int kk, int ch) { return ld_f32x8_as_bf16(kb + (size_t)kk * 256 + ch * 8); },
      [&](int kk, int ch) { return ld_f32x8_as_bf16(vb + (size_t)kk * 256 + ch * 8); },
      [&](int, int row, int ko) { return row < 4 ? *(const u32x4*)(qb + (size_t)row * ZLD + ko) : zero4(); },
      [&](int, int, int) { return true; },
      [&](int, int) { return 0.f; },
      [&](int, int row) { return ob + (size_t)row * 1024; });
}

__device__ __forceinline__ void swa_prompt_item(PP p, int jl, int it, unsigned char* smem) {
  const int kvh = it & 3, hb = it >> 2;
  const int tok0 = hb * 64, b = tok0 >> 13, q0 = tok0 & 8191;
  const u16* zb = p->z + (size_t)(b * 8192) * ZLD;
  const u16* qb = p->z + (size_t)tok0 * ZLD + kvh * 192;
  u16* ob = p->mix + (size_t)tok0 * 1024 + kvh * 192;
  const float sk0 = p->a_sink[jl * 12 + kvh * 3], sk1 = p->a_sink[jl * 12 + kvh * 3 + 1], sk2 = p->a_sink[jl * 12 + kvh * 3 + 2];
  attn_core<192, true, 3>((u16*)smem, 64,
      [&](int kk, int ch) { const int kp = q0 - 128 + kk; return kp >= 0 ? *(const u32x4*)(zb + (size_t)kp * ZLD + 768 + kvh * 64 + ch * 8) : zero4(); },
      [&](int kk, int ch) { const int kp = q0 - 128 + kk; return kp >= 0 ? *(const u32x4*)(zb + (size_t)kp * ZLD + 1024 + kvh * 64 + ch * 8) : zero4(); },
      [&](int sub, int row, int ko) { return *(const u32x4*)(qb + (size_t)row * ZLD + sub * 64 + ko); },
      [&](int, int row, int kk) { const int qp = q0 + row, kp = q0 - 128 + kk; return kp >= 0 && kp <= qp && qp - kp < 128; },
      [&](int sub, int) { return sub == 0 ? sk0 : (sub == 1 ? sk1 : sk2); },
      [&](int sub, int row) { return ob + (size_t)row * 1024 + sub * 64; });
}

__device__ __forceinline__ void swa_sample_item(PP p, int jl, int it, unsigned char* smem) {
  const int kvh = it & 3, b = it >> 2;
  const float* ck = p->cache_swa_k + ((size_t)(jl * 128 + b) * 128) * 256 + kvh * 64;
  const float* cv = p->cache_swa_v + ((size_t)(jl * 128 + b) * 128) * 256 + kvh * 64;
  const int tok0 = T_P + b * 4;
  const u16* zb = p->z + (size_t)tok0 * ZLD;
  u16* ob = p->mix + (size_t)tok0 * 1024;
  const float* sk = p->a_sink + jl * 12 + kvh * 3;
  attn_core<160, true, 1>((u16*)smem, 12,
      [&](int kk, int ch) {
        if (kk < 128) return ld_f32x8_as_bf16(ck + (size_t)kk * 256 + ch * 8);
        if (kk < 132) return *(const u32x4*)(zb + (size_t)(kk - 128) * ZLD + 768 + kvh * 64 + ch * 8);
        return zero4(); },
      [&](int kk, int ch) {
        if (kk < 128) return ld_f32x8_as_bf16(cv + (size_t)kk * 256 + ch * 8);
        if (kk < 132) return *(const u32x4*)(zb + (size_t)(kk - 128) * ZLD + 1024 + kvh * 64 + ch * 8);
        return zero4(); },
      [&](int, int row, int ko) { return row < 12 ? *(const u32x4*)(zb + (size_t)(row / 3) * ZLD + (kvh * 3 + row % 3) * 64 + ko) : zero4(); },
      [&](int, int row, int kk) { const int t = row / 3; return kk < 128 ? (kk > t) : (kk < 132 && (kk - 128) <= t); },
      [&](int, int row) { return row < 12 ? sk[row % 3] : 0.f; },
      [&](int, int row) { return ob + (size_t)(row / 3) * 1024 + (kvh * 3 + row % 3) * 64; });
}

__device__ __forceinline__ void phase_mixer(PP p, int layer, unsigned char* smem) {
  const int jl = layer >> 1;
  if (!(layer & 1)) {
    for (int it = bid_opaque(); it < 2560; it += gridDim.x) {
      if (it < 1024) swa_prompt_item(p, jl, it, smem);
      else if (it < 1536) mem_prompt_item(p, layer, it - 1024, smem);
      else if (it < 2048) swa_sample_item(p, jl, it - 1536, smem);
      else mem_sample_item(p, layer, it - 2048, smem);
    }
  } else {
    for (int it = bid_opaque(); it < 1664; it += gridDim.x) {
      if (it < 512) sg_prompt_item(p, jl, it, smem);
      else if (it < 1024) mem_prompt_item(p, layer, it - 512, smem);
      else if (it < 1152) sg_sample_item(p, jl, it - 1024, smem);
      else mem_sample_item(p, layer, it - 1152, smem);
    }
  }
}

__device__ __forceinline__ void phase_outproj(PP p, int layer, unsigned char* smem) {
  const int tid = tid_opaque(), lane = tid & 63, w = tid >> 6, wm = w >> 1, wn = w & 1, quad = lane >> 4, lc = lane & 15;
  const u16* W = p->wT_out + (size_t)layer * 1024 * 1024;
  for (int t = bid_opaque(); t < 132 * 8; t += gridDim.x) {
    const int tx = xcd_tile(t, 132 * 8);
    const int tm = tx >> 3, tn = tx & 7;
    f32x4 acc[4][4];
    gemm128(p->mix + (size_t)tm * 128 * 1024, 1024, W + (size_t)tn * 128 * 1024, 1024, 1024, (u16*)smem, acc);
    float* Cs = (float*)smem;
#pragma unroll
    for (int i = 0; i < 4; i++)
#pragma unroll
      for (int j = 0; j < 4; j++)
#pragma unroll
        for (int r = 0; r < 4; r++) Cs[(wm * 64 + i * 16 + quad * 4 + r) * 132 + wn * 64 + j * 16 + lc] = acc[i][j][r];
    __syncthreads();
    const size_t gbase = (size_t)(tm * 128) * 1024 + tn * 128 + (tid & 31) * 4;
#pragma unroll
    for (int hb = 0; hb < 2; hb++) {
      u32x2 res[8];
#pragma unroll
      for (int it = 0; it < 8; it++) res[it] = *(const u32x2*)(p->xb + gbase + (size_t)((hb * 8 + it) * 8 + (tid >> 5)) * 1024);
#pragma unroll
      for (int it = 0; it < 8; it++) {
        const int row = (hb * 8 + it) * 8 + (tid >> 5);
        const f32x4 c = *(const f32x4*)(Cs + row * 132 + (tid & 31) * 4);
        const f32x4 xr = {bflo(res[it].x), bfhi(res[it].x), bflo(res[it].y), bfhi(res[it].y)};
        const f32x4 v = DN_ALPHA_F * xr + c;
        *(u32x2*)(p->preb + gbase + (size_t)row * 1024) = u32x2{pack_bf16(v.x, v.y), pack_bf16(v.z, v.w)};
      }
    }
    __syncthreads();
  }
  convert_tables_part(p, layer, 1);
}

__device__ __forceinline__ void phase_ln1(PP p, int layer) {
  const int tid = tid_opaque(), lane = tid & 63, w = tid >> 6;
  const float* g = p->ln1_g + layer * 1024 + lane * 16;
  const float* bb = p->ln1_b + layer * 1024 + lane * 16;
  for (int tok = bid_opaque() * 4 + w; tok < T_ALL; tok += gridDim.x * 4) {
    const u32x4* pr = (const u32x4*)(p->preb + (size_t)tok * 1024 + lane * 16);
    const u32x4 q0 = pr[0], q1 = pr[1];
    f32x4 gg[4], bv[4];
#pragma unroll
    for (int i = 0; i < 4; i++) { gg[i] = *(const f32x4*)(g + i * 4); bv[i] = *(const f32x4*)(bb + i * 4); }
    float v[16];
#pragma unroll
    for (int e = 0; e < 4; e++) { v[2 * e] = bflo(q0[e]); v[2 * e + 1] = bfhi(q0[e]); v[8 + 2 * e] = bflo(q1[e]); v[8 + 2 * e + 1] = bfhi(q1[e]); }
    float sum = 0.f;
#pragma unroll
    for (int i = 0; i < 16; i++) sum += v[i];
    const float mu = wave_sum(sum) * (1.0f / 1024.0f);
    float sq = 0.f;
#pragma unroll
    for (int i = 0; i < 16; i++) { const float d = v[i] - mu; sq += d * d; }
    const float rs = rsqrtf(wave_sum(sq) * (1.0f / 1024.0f) + LN_EPS_F);
    f32x4 o[4];
#pragma unroll
    for (int i = 0; i < 4; i++) {
      o[i].x = (v[i * 4] - mu) * rs * gg[i].x + bv[i].x; o[i].y = (v[i * 4 + 1] - mu) * rs * gg[i].y + bv[i].y;
      o[i].z = (v[i * 4 + 2] - mu) * rs * gg[i].z + bv[i].z; o[i].w = (v[i * 4 + 3] - mu) * rs * gg[i].w + bv[i].w;
    }
    u32x4* xo = (u32x4*)(p->xb + (size_t)tok * 1024 + lane * 16);
    xo[0] = cvt8(o[0], o[1]);
    xo[1] = cvt8(o[2], o[3]);
  }
}

__device__ __forceinline__ void phase_peerq(PP p, int layer, unsigned char* smem) {
  const int tid = tid_opaque(), lane = tid & 63, w = tid >> 6, wm = w >> 1, wn = w & 1, quad = lane >> 4, lc = lane & 15;
  const u16* W = p->wT_pq + (size_t)layer * 2048 * 1024;
  const float* bq = p->peer_b_q + layer * 2048;
  u16* Qs = (u16*)smem;
  uint32_t* Sk = (uint32_t*)smem;
  for (int t = bid_opaque(); t < 132 * 16; t += gridDim.x) {
    const int tx = xcd_tile(t, 132 * 16);
    const int tm = tx >> 4, tn = tx & 15;
    f32x4 acc[4][4];
    gemm128(p->xb + (size_t)tm * 128 * 1024, 1024, W + (size_t)tn * 128 * 1024, 1024, 1024, (u16*)smem, acc);
#pragma unroll
    for (int i = 0; i < 4; i++)
#pragma unroll
      for (int j = 0; j < 4; j++) {
        const int col = wn * 64 + j * 16 + lc;
        const float bias = bq[tn * 128 + col];
#pragma unroll
        for (int r = 0; r < 4; r++) Qs[(wm * 64 + i * 16 + quad * 4 + r) * 136 + col] = f2bf(acc[i][j][r] + bias);
      }
    __syncthreads();
    const u16* sk = p->subk + ((size_t)layer * 16 + tn) * 128 * 128;
#pragma unroll
    for (int i = 0; i < 4; i++)
#pragma unroll
      for (int j = 0; j < 4; j++) acc[i][j] = f32x4{0.f, 0.f, 0.f, 0.f};
#pragma unroll
    for (int ks = 0; ks < 4; ks++) {
      bf16x8 af[4], bfr[4];
#pragma unroll
      for (int i = 0; i < 4; i++) af[i] = *(const bf16x8*)(Qs + (wm * 64 + i * 16 + lc) * 136 + ks * 32 + quad * 8);
#pragma unroll
      for (int j = 0; j < 4; j++) bfr[j] = *(const bf16x8*)(sk + (size_t)(wn * 64 + j * 16 + lc) * 128 + ks * 32 + quad * 8);
#pragma unroll
      for (int i = 0; i < 4; i++)
#pragma unroll
        for (int j = 0; j < 4; j++) acc[i][j] = __builtin_amdgcn_mfma_f32_16x16x32_bf16(af[i], bfr[j], acc[i][j], 0, 0, 0);
    }
    __syncthreads();
#pragma unroll
    for (int i = 0; i < 4; i++)
#pragma unroll
      for (int j = 0; j < 4; j++) {
        const int n = wn * 64 + j * 16 + lc;
#pragma unroll
        for (int r = 0; r < 4; r++) {
          const uint32_t u = __float_as_uint(acc[i][j][r]);
          const uint32_t m = (u & 0x80000000u) ? ~u : (u | 0x80000000u);
          Sk[(wm * 64 + i * 16 + quad * 4 + r) * 129 + n] = (m & ~127u) | (uint32_t)(127 - n);
        }
      }
    __syncthreads();
    if (tid < 128) {
      uint32_t k[128];
#pragma unroll
      for (int e = 0; e < 128; e++) k[e] = Sk[tid * 129 + e];
#pragma unroll
      for (int size = 2; size <= 16; size <<= 1) {
#pragma unroll
        for (int stride = size >> 1; stride > 0; stride >>= 1) {
#pragma unroll
          for (int i = 0; i < 128; i++) {
            const int j = i ^ stride;
            if (j > i) {
              const uint32_t mx = k[i] > k[j] ? k[i] : k[j], mn = k[i] > k[j] ? k[j] : k[i];
              if ((i & size) == 0) { k[i] = mx; k[j] = mn; } else { k[i] = mn; k[j] = mx; }
            }
          }
        }
      }
#pragma unroll
      for (int ng = 4; ng >= 1; ng >>= 1) {
#pragma unroll
        for (int m = 0; m < ng; m++) {
#pragma unroll
          for (int i = 0; i < 16; i++) {
            const uint32_t a = k[(2 * m) * 16 + i], b = k[(2 * m + 1) * 16 + i];
            k[m * 16 + i] = a > b ? a : b;
          }
        }
#pragma unroll
        for (int stride = 8; stride > 0; stride >>= 1) {
#pragma unroll
          for (int i = 0; i < 16 * ng; i++) {
            const int j = i ^ stride;
            if (j > i) {
              const uint32_t mx = k[i] > k[j] ? k[i] : k[j], mn = k[i] > k[j] ? k[j] : k[i];
              if ((i & 16) == 0) { k[i] = mx; k[j] = mn; } else { k[i] = mn; k[j] = mx; }
            }
          }
        }
      }
      u32x4* o = (u32x4*)(p->topk + ((size_t)(tm * 128 + tid) * 16 + tn) * 16);
#pragma unroll
      for (int q = 0; q < 4; q++) {
        u32x4 v;
#pragma unroll
        for (int e = 0; e < 4; e++) { const uint32_t b = k[q * 4 + e]; v[e] = (b & ~127u) | (127u - (b & 127u)); }
        o[q] = v;
      }
    }
    __syncthreads();
  }
  convert_tables_part(p, layer, 2);
}

__device__ __forceinline__ float dec_key(uint32_t key) {
  const uint32_t m = key & ~127u;
  return __uint_as_float((m & 0x80000000u) ? (m ^ 0x80000000u) : ~m);
}

__device__ __forceinline__ void phase_gather(PP p, int layer, unsigned char* smem) {
  const int tid = tid_opaque(), lane = tid & 63, w = tid >> 6;
  const int hl = lane & 31;
  const bool hi_half = lane >= 32;
  const unsigned char* ubl = p->ub + (size_t)layer * 16384 * 1280 + hl * 24;
  const unsigned char* vbl = p->ub + (size_t)layer * 16384 * 1280 + 768 + hl * 16;
  const float* g2 = p->ln2_g + layer * 1024;
  const float* b2 = p->ln2_b + layer * 1024;
  const int ci = c_cand[lane] >> 4, cj = c_cand[lane] & 15;
  float* xo = p->y_out;
  u32x2* selw = (u32x2*)smem + w * 512 + lane;
  for (int tok = bid_opaque() * 4 + w; tok < T_ALL; tok += gridDim.x * 4) {
    f32x32 x, y;
    {
      const u32x4* xr = (const u32x4*)(p->xb + (size_t)tok * 1024 + hl * 32);
#pragma unroll
      for (int i = 0; i < 4; i++) {
        const u32x4 a = xr[i];
#pragma unroll
        for (int e = 0; e < 4; e++) { x[i * 8 + 2 * e] = bflo(a[e]); x[i * 8 + 2 * e + 1] = bfhi(a[e]); }
      }
    }
#pragma unroll
    for (int i = 0; i < 32; i++) y[i] = 0.f;
    u32x2 wu[8][3];
    u32x4 wv[8];
    int e[16];
    uint32_t k0n = p->topk[(size_t)tok * 256 + ci], k1n = p->topk[(size_t)tok * 256 + 16 + cj];
    for (int h = 0; h < 8; h++) {
      const uint32_t k0 = k0n, k1 = k1n;
      if (h + 1 < 8) { const uint32_t* tk = p->topk + ((size_t)tok * 16 + (h + 1) * 2) * 16; k0n = tk[ci]; k1n = tk[16 + cj]; }
      float cand = dec_key(k0) + dec_key(k1);
      int eid = (int)((k0 & 127u) * 128u + (k1 & 127u));
      uint32_t ckey;
      {
        const uint32_t u = __float_as_uint(cand);
        const uint32_t m = (u & 0x80000000u) ? ~u : (u | 0x80000000u);
        ckey = (lane < 50) ? ((m & ~63u) | (uint32_t)(63 - lane)) : 0u;
      }
      int rank = 0;
#pragma unroll
      for (int l2 = 0; l2 < 50; l2++) {
        const uint32_t o = (uint32_t)__builtin_amdgcn_readlane((int)ckey, l2);
        rank += (o > ckey) ? 1 : 0;
      }
      const int dst = (rank < 16) ? ((rank & 1) * 32 + (rank >> 1) * 4) : 1;
      const float fsel = __int_as_float(__builtin_amdgcn_ds_permute(dst * 4, __float_as_int(cand)));
      const int esel = __builtin_amdgcn_ds_permute(dst * 4, eid);
      const float f0 = __int_as_float(__builtin_amdgcn_readlane(__float_as_int(fsel), 0));
      float ev = ((lane & 3) == 0) ? __expf(fsel - f0) : 0.f;
      float es = ev;
      es += __shfl_xor(es, 4); es += __shfl_xor(es, 8); es += __shfl_xor(es, 16); es += __shfl_xor(es, 32);
      const float gate = ev / es;
      selw[h * 64] = u32x2{(uint32_t)esel, __float_as_uint(gate)};
      if (h == 0) {
#pragma unroll
        for (int k = 0; k < 16; k++) e[k] = __builtin_amdgcn_readlane(esel, (k & 1) * 32 + (k >> 1) * 4);
#pragma unroll
        for (int m = 0; m < 8; m++) {
          const u32x2* rp = (const u32x2*)(ubl + (size_t)(hi_half ? e[2 * m + 1] : e[2 * m]) * 1280);
          wu[m][0] = rp[0]; wu[m][1] = rp[1]; wu[m][2] = rp[2];
        }
#pragma unroll
        for (int m = 0; m < 8; m++) wv[m] = *(const u32x4*)(vbl + (size_t)(hi_half ? e[2 * m + 1] : e[2 * m]) * 1280);
      }
    }
    for (int h = 0; h < 8; h++) {
      float pd[8];
#pragma unroll
      for (int m = 0; m < 8; m++) {
        const u32x6 pk = {wu[m][0].x, wu[m][0].y, wu[m][1].x, wu[m][1].y, wu[m][2].x, wu[m][2].y};
        const f32x32 f = __builtin_amdgcn_cvt_scalef32_pk32_f32_fp6(pk, 1.0f);
        f32x2 a0 = {0.f, 0.f}, a1 = {0.f, 0.f};
#pragma unroll
        for (int i = 0; i < 8; i++) {
          a0 += f32x2{f[4 * i], f[4 * i + 1]} * f32x2{x[4 * i], x[4 * i + 1]};
          a1 += f32x2{f[4 * i + 2], f[4 * i + 3]} * f32x2{x[4 * i + 2], x[4 * i + 3]};
        }
        pd[m] = (a0.x + a0.y) + (a1.x + a1.y);
        __builtin_amdgcn_sched_barrier(0);
      }
      const float gate = __uint_as_float(selw[h * 64].y);
      if (h + 1 < 8) {
        const int esn = (int)selw[(h + 1) * 64].x;
#pragma unroll
        for (int k = 0; k < 16; k++) e[k] = __builtin_amdgcn_readlane(esn, (k & 1) * 32 + (k >> 1) * 4);
#pragma unroll
        for (int m = 0; m < 8; m++) {
          const u32x2* rp = (const u32x2*)(ubl + (size_t)(hi_half ? e[2 * m + 1] : e[2 * m]) * 1280);
          wu[m][0] = rp[0]; wu[m][1] = rp[1]; wu[m][2] = rp[2];
        }
      }
      __builtin_amdgcn_sched_barrier(0);
      float q4[4], q2[2], q1;
      {
        const bool hi = lane & 16;
#pragma unroll
        for (int k = 0; k < 4; k++) { const float give = hi ? pd[k] : pd[k + 4]; const float keep = hi ? pd[k + 4] : pd[k]; q4[k] = keep + __shfl_xor(give, 16); }
      }
      {
        const bool hi = lane & 8;
#pragma unroll
        for (int k = 0; k < 2; k++) { const float give = hi ? q4[k] : q4[k + 2]; const float keep = hi ? q4[k + 2] : q4[k]; q2[k] = keep + __shfl_xor(give, 8); }
      }
      {
        const bool hi = lane & 4;
        const float give = hi ? q2[0] : q2[1]; const float keep = hi ? q2[1] : q2[0];
        q1 = keep + __shfl_xor(give, 4);
      }
      q1 += __shfl_xor(q1, 2);
      q1 += __shfl_xor(q1, 1);
      const float aval = gate * gelu_exact(q1 * (1.0f / PEER_SU)) * (1.0f / PEER_SV);
      __builtin_amdgcn_sched_barrier(0);
#pragma unroll
      for (int m = 0; m < 8; m++) {
        const float alo = __int_as_float(__builtin_amdgcn_readlane(__float_as_int(aval), 4 * m));
        const float ahi = __int_as_float(__builtin_amdgcn_readlane(__float_as_int(aval), 32 + 4 * m));
        const float a = hi_half ? ahi : alo;
        const f32x2 a2 = {a, a};
#define FP4_ACC(WD, BS) { const f32x2 f = __builtin_amdgcn_cvt_scalef32_pk_f32_fp4(wv[m][WD], 1.0f, BS); \
          const f32x2 r = f32x2{y[2 * (WD * 4 + BS)], y[2 * (WD * 4 + BS) + 1]} + a2 * f; y[2 * (WD * 4 + BS)] = r.x; y[2 * (WD * 4 + BS) + 1] = r.y; }
#define FP4_ACC4(WD) FP4_ACC(WD, 0) FP4_ACC(WD, 1) FP4_ACC(WD, 2) FP4_ACC(WD, 3)
        FP4_ACC4(0) FP4_ACC4(1) FP4_ACC4(2) FP4_ACC4(3)
        __builtin_amdgcn_sched_barrier(0);
      }
      if (h + 1 < 8) {
#pragma unroll
        for (int m = 0; m < 8; m++) wv[m] = *(const u32x4*)(vbl + (size_t)(hi_half ? e[2 * m + 1] : e[2 * m]) * 1280);
      }
      __builtin_amdgcn_sched_barrier(0);
    }
    float sum = 0.f;
#pragma unroll
    for (int i = 0; i < 32; i++) { y[i] += __shfl_xor(y[i], 32); y[i] = fmaf(DN_ALPHA_F, x[i], y[i]); sum += y[i]; }
    sum += __shfl_xor(sum, 16); sum += __shfl_xor(sum, 8); sum += __shfl_xor(sum, 4); sum += __shfl_xor(sum, 2); sum += __shfl_xor(sum, 1);
    const float mu = sum * (1.0f / 1024.0f);
    float sq = 0.f;
#pragma unroll
    for (int i = 0; i < 32; i++) { const float d = y[i] - mu; sq += d * d; }
    sq += __shfl_xor(sq, 16); sq += __shfl_xor(sq, 8); sq += __shfl_xor(sq, 4); sq += __shfl_xor(sq, 2); sq += __shfl_xor(sq, 1);
    const float rs = rsqrtf(sq * (1.0f / 1024.0f) + LN_EPS_F);
    f32x4 ga[8], ba[8];
#pragma unroll
    for (int i = 0; i < 8; i++) { ga[i] = *(const f32x4*)(g2 + hl * 32 + i * 4); ba[i] = *(const f32x4*)(b2 + hl * 32 + i * 4); }
    f32x4 o[8];
#pragma unroll
    for (int i = 0; i < 8; i++) {
      o[i].x = (y[i * 4 + 0] - mu) * rs * ga[i].x + ba[i].x; o[i].y = (y[i * 4 + 1] - mu) * rs * ga[i].y + ba[i].y;
      o[i].z = (y[i * 4 + 2] - mu) * rs * ga[i].z + ba[i].z; o[i].w = (y[i * 4 + 3] - mu) * rs * ga[i].w + ba[i].w;
    }
    if (!hi_half) {
      if (layer == 3) {
#pragma unroll
        for (int i = 0; i < 8; i++) *(f32x4*)(xo + (size_t)tok * 1024 + hl * 32 + i * 4) = o[i];
      }
    } else {
#pragma unroll
      for (int i = 0; i < 4; i++) *(u32x4*)(p->xb + (size_t)tok * 1024 + hl * 32 + i * 8) = cvt8(o[2 * i], o[2 * i + 1]);
    }
  }
}

#define XB_TMO      128
#define XB_XCNT(j)  (256  + 64 * (j))
#define XB_XSUB(j)  (1280 + 64 * (j))
#define XB_XGEN(j)  (2304 + 64 * (j))
#define XB_TOP      3328
#define XB_TOPGEN   3392
#define XCD_BAR_WORDS 3456
#define XB_SPIN_CAP (1u << 18)
#define LAS __attribute__((address_space(3)))
__device__ __forceinline__ unsigned xb_ld(unsigned* p)              { return __hip_atomic_load(p, __ATOMIC_RELAXED, __HIP_MEMORY_SCOPE_AGENT); }
__device__ __forceinline__ unsigned xb_add(unsigned* p, unsigned v) { return __hip_atomic_fetch_add(p, v, __ATOMIC_RELAXED, __HIP_MEMORY_SCOPE_AGENT); }
__device__ __forceinline__ unsigned xb_xcc_id() { return (unsigned)__builtin_amdgcn_s_getreg((3 << 11) | 20) & 0xFu; }
#define XB_SPIN(cond, bar) do { unsigned _sp = 0; while (cond) { __builtin_amdgcn_s_sleep(1); \
    if ((++_sp & 255u) == 0u) { if (xb_ld(&(bar)[XB_TMO])) break; if (_sp > XB_SPIN_CAP) { atomicAdd(&(bar)[XB_TMO], 1u); break; } } } } while (0)
struct XcdBarrier { unsigned* bar; unsigned x; volatile LAS unsigned* st; };
__device__ __forceinline__ XcdBarrier xcd_barrier_post(unsigned* bar, volatile LAS unsigned* st) {
  XcdBarrier b; b.bar = bar; b.x = xb_xcc_id(); b.st = st;
  if (threadIdx.x == 0) (void)xb_add(&bar[XB_XCNT(b.x)], 1u);
  return b;
}
__device__ __forceinline__ void xcd_barrier_complete(unsigned* bar, unsigned x, unsigned& nloc, unsigned& nx) {
  const unsigned G = gridDim.x * gridDim.y * gridDim.z;
  unsigned sum, cnt, mine, sp = 0u;
  for (;;) {
    sum = 0u; cnt = 0u; mine = 0u;
#pragma unroll
    for (unsigned j = 0; j < 16; ++j) { const unsigned c = xb_ld(&bar[XB_XCNT(j)]); sum += c; cnt += (c > 0u) ? 1u : 0u; mine = (j == x) ? c : mine; }
    if (sum == G) break;
    __builtin_amdgcn_s_sleep(1);
    if ((++sp & 255u) == 0u) { if (xb_ld(&bar[XB_TMO])) break; if (sp > XB_SPIN_CAP) { atomicAdd(&bar[XB_TMO], 1u); break; } }
  }
  nloc = mine > 0u ? mine : 1u; nx = cnt > 0u ? cnt : 1u;
}
__device__ __forceinline__ void xcd_barrier(const XcdBarrier& b) {
  asm volatile("s_waitcnt vmcnt(0)" ::: "memory");
  __syncthreads();
  if (threadIdx.x == 0) {
    unsigned* bar = b.bar;
    __builtin_amdgcn_s_waitcnt(0);
    unsigned nloc = b.st[0], nx = b.st[1];
    if (nloc == 0u) { xcd_barrier_complete(bar, b.x, nloc, nx); b.st[0] = nloc; b.st[1] = nx; }
    const unsigned old = xb_add(&bar[XB_XSUB(b.x)], 1u);
    const unsigned gen = old / nloc;
    if (old + 1u == (gen + 1u) * nloc) {
      __builtin_amdgcn_fence(__ATOMIC_RELEASE, "agent");
      asm volatile("s_waitcnt vmcnt(0)" ::: "memory");
      const unsigned og = xb_add(&bar[XB_TOP], 1u);
      const unsigned tg = og / nx;
      if (og + 1u == (tg + 1u) * nx) xb_add(&bar[XB_TOPGEN], 1u);
      else XB_SPIN(xb_ld(&bar[XB_TOPGEN]) == tg, bar);
      __builtin_amdgcn_fence(__ATOMIC_ACQUIRE, "agent");
      xb_add(&bar[XB_XGEN(b.x)], 1u);
      asm volatile("s_waitcnt vmcnt(0)" ::: "memory");
    } else {
      XB_SPIN(xb_ld(&bar[XB_XGEN(b.x)]) == gen, bar);
      __builtin_amdgcn_fence(__ATOMIC_ACQUIRE, "agent");
      asm volatile("s_waitcnt vmcnt(0)" ::: "memory");
    }
  }
  __syncthreads();
}

__global__ void __launch_bounds__(256, 2) mega(Params p_arg, int ph_lo, int ph_hi, int coop) {
  __shared__ __attribute__((aligned(16))) unsigned char smem[SMEM_BYTES];
  __shared__ u32x4 xb_words;
  cg::grid_group grid = cg::this_grid();
  if (threadIdx.x == 0) xb_words = u32x4{0u, 0u, 0u, 0u};
  __syncthreads();
  if (coop) (void)xcd_barrier_post(((PP)__builtin_amdgcn_kernarg_segment_ptr())->bar, (volatile LAS unsigned*)&xb_words);
  for (int ph = ph_lo; ph < ph_hi; ph++) {
    const int reps = (int)((PROBE_MASK >> ph) & 1u) + 1;
    for (int rep = 0; rep < reps; rep++) {
      PP p = (PP)__builtin_amdgcn_kernarg_segment_ptr();
      asm volatile("" : "+s"(p));
      if (ph == 0) {
        phase_prologue(p, smem);
      } else {
        const int layer = (ph - 1) / 6, k = (ph - 1) % 6;
        switch (k) {
          case 0: phase_inproj(p, layer, smem); break;
          case 1: phase_mixer(p, layer, smem); break;
          case 2: phase_outproj(p, layer, smem); break;
          case 3: phase_ln1(p, layer); break;
          case 4: phase_peerq(p, layer, smem); break;
          default: phase_gather(p, layer, smem); break;
        }
      }
      if (coop == 1 && (rep + 1 < reps || ph + 1 < ph_hi)) {
        XcdBarrier xb; xb.bar = p->bar; xb.x = xb_xcc_id(); xb.st = (volatile LAS unsigned*)&xb_words;
        xcd_barrier(xb);
      }
      if (coop == 2) grid.sync();
    }
  }
}

extern "C" void kernel_launch(void* const* d_in, const int* in_sizes, int n_in, void* d_out, int out_size, void* d_ws,
                              size_t ws_size, hipStream_t stream) {
  Params p{};
  p.x_prompt = (const float*)d_in[0]; p.x_sample = (const float*)d_in[1];
  p.cache_swa_k = (const float*)d_in[2]; p.cache_swa_v = (const float*)d_in[3];
  p.cache_mem_k = (const float*)d_in[4]; p.cache_mem_v = (const float*)d_in[5];
  p.mem_prompt = (const float*)d_in[6];
  p.a_w_in = (const float*)d_in[7]; p.a_sink = (const float*)d_in[8]; p.b_w_in = (const float*)d_in[9];
  p.b_v_ln_g = (const float*)d_in[10]; p.b_v_ln_b = (const float*)d_in[11]; p.b_w_s = (const float*)d_in[12];
  p.b_b_s = (const float*)d_in[13]; p.w_mem_kv = (const float*)d_in[14]; p.w_out = (const float*)d_in[15];
  p.ln1_g = (const float*)d_in[16]; p.ln1_b = (const float*)d_in[17]; p.ln2_g = (const float*)d_in[18]; p.ln2_b = (const float*)d_in[19];
  p.peer_w_q = (const float*)d_in[20]; p.peer_b_q = (const float*)d_in[21]; p.peer_subkeys = (const float*)d_in[22];
  p.peer_u = (const float*)d_in[23]; p.peer_v = (const float*)d_in[24];
  float* o = (float*)d_out;
  p.y_out = o;                       o += (size_t)T_ALL * 1024;
  p.swa_k_prompt = o;                o += 131072;
  p.swa_v_prompt = o;                o += 131072;
  p.swa_k_sample = o;                o += 262144;
  p.swa_v_sample = o;                o += 262144;
  p.sg_v_sample = o;                 o += 786432;
  p.mem_k_prompt = o;                o += 524288;
  p.mem_v_prompt = o;
  unsigned char* wsb = (unsigned char*)d_ws;
  size_t off = 0;
  auto carve = [&](size_t bytes) { void* r = wsb + off; off += (bytes + 255) & ~(size_t)255; return r; };
  p.wT_a_in = (u16*)carve((size_t)2 * 1536 * 1024 * 2);
  p.wT_b_in = (u16*)carve((size_t)2 * 1792 * 1024 * 2);
  p.wT_memkv = (u16*)carve((size_t)4 * 512 * 1024 * 2);
  p.wT_out = (u16*)carve((size_t)4 * 1024 * 1024 * 2);
  p.wT_pq = (u16*)carve((size_t)4 * 2048 * 1024 * 2);
  p.subk = (u16*)carve((size_t)4 * 8 * 2 * 128 * 128 * 2);
  p.ub = (unsigned char*)carve((size_t)4 * 16384 * 1280);
  p.vb = p.ub;
  p.memb = (u16*)carve((size_t)512 * 1024 * 2);
  p.xb = (u16*)carve((size_t)T_ALL * 1024 * 2);
  p.z = (u16*)carve((size_t)T_ALL * ZLD * 2);
  p.mix = (u16*)carve((size_t)T_ALL * 1024 * 2);
  p.mkvp = (u16*)carve((size_t)4 * 2 * 512 * 256 * 2);
  p.preb = (u16*)carve((size_t)T_ALL * 1024 * 2);
  p.ropecs = (float*)carve((size_t)8196 * 8 * 2 * 4);
  p.topk = (uint32_t*)carve((size_t)T_ALL * 16 * 16 * 4);
  p.bar = (unsigned*)carve((size_t)XCD_BAR_WORDS * 4);
  if (off > ws_size) { fprintf(stderr, "workspace too small: need %zu have %zu\n", off, ws_size); return; }

  static int grid_blocks = 0;
  if (!grid_blocks) {
    int dev = 0, cus = 0, per_cu = 0;
    (void)hipGetDevice(&dev);
    (void)hipDeviceGetAttribute(&cus, hipDeviceAttributeMultiprocessorCount, dev);
    (void)hipOccupancyMaxActiveBlocksPerMultiprocessor(&per_cu, mega, 256, 0);
    if (per_cu < 1) per_cu = 1;
    if (per_cu > 2) per_cu = 2;
    grid_blocks = cus * per_cu;
  }
#if MK_MULTI
  for (int ph = 0; ph < N_PHASES; ph++) mega<<<dim3(grid_blocks), dim3(256), 0, stream>>>(p, ph, ph + 1, 0);
#else
  (void)hipMemsetAsync(p.bar, 0, (size_t)XCD_BAR_WORDS * 4, stream);
  int lo = 0, hi = N_PHASES, coop = 1;
  void* args[] = {&p, &lo, &hi, &coop};
  hipError_t e = hipLaunchCooperativeKernel((void*)mega, dim3(grid_blocks), dim3(256), args, 0, stream);
  if (e != hipSuccess) fprintf(stderr, "cooperative launch failed: %s (grid %d)\n", hipGetErrorString(e), grid_blocks);
#endif
}
```

```cpp
#include <hip/hip_runtime.h>
#include <hip/hip_cooperative_groups.h>
#include <stdint.h>
#include <cstdio>
namespace cg = cooperative_groups;

#ifndef MK_MULTI
#define MK_MULTI 0
#endif

typedef unsigned short u16;
typedef __attribute__((ext_vector_type(8))) short bf16x8;
typedef __attribute__((ext_vector_type(4))) float f32x4;
typedef __attribute__((ext_vector_type(2))) float f32x2;
typedef __attribute__((ext_vector_type(4))) unsigned int u32x4;
typedef __attribute__((ext_vector_type(2))) unsigned int u32x2;
typedef __attribute__((ext_vector_type(6))) unsigned int u32x6;
typedef __attribute__((ext_vector_type(16))) float f32x16;
typedef __attribute__((ext_vector_type(32))) float f32x32;

#define T_P 16384
#define T_ALL 16896
#define ZLD 1792
#define SMEM_BYTES 73728
#define DN_ALPHA_F 1.6817928305074292f
#define LN_EPS_F 1e-5f
#define N_PHASES 25
#define PEER_SU 48.0f
#define PEER_SV 12.0f
#ifndef PROBE_MASK
#define PROBE_MASK 0u
#endif

struct Params {
  const float *x_prompt, *x_sample, *cache_swa_k, *cache_swa_v, *cache_mem_k, *cache_mem_v, *mem_prompt;
  const float *a_w_in, *a_sink, *b_w_in, *b_v_ln_g, *b_v_ln_b, *b_w_s, *b_b_s, *w_mem_kv, *w_out;
  const float *ln1_g, *ln1_b, *ln2_g, *ln2_b, *peer_w_q, *peer_b_q, *peer_subkeys, *peer_u, *peer_v;
  float *y_out, *swa_k_prompt, *swa_v_prompt, *swa_k_sample, *swa_v_sample, *sg_v_sample, *mem_k_prompt, *mem_v_prompt;
  u16 *wT_a_in, *wT_b_in, *wT_memkv, *wT_out, *wT_pq, *subk, *memb, *xb, *z, *mix, *mkvp;
  unsigned char *ub, *vb;
  float *ropecs;
  u16 *preb;
  uint32_t *topk;
  unsigned *bar;
};

typedef const __attribute__((address_space(4))) Params* PP;

__constant__ double c_rope_inv[8] = {1.0, 0.19392274474868576, 0.03760603093086393, 0.007292664737217109,
  0.001414213562373095, 0.0002742481756762073, 5.318295896944988e-05, 1.031338537721246e-05};
__constant__ unsigned char c_cand[64] = {
  0x00,0x01,0x02,0x03,0x04,0x05,0x06,0x07,0x08,0x09,0x0a,0x0b,0x0c,0x0d,0x0e,0x0f,0x10,0x11,0x12,0x13,0x14,0x15,0x16,0x17,
  0x20,0x21,0x22,0x23,0x24,0x30,0x31,0x32,0x33,0x40,0x41,0x42,0x50,0x51,0x60,0x61,0x70,0x71,0x80,0x90,0xa0,0xb0,0xc0,0xd0,
  0xe0,0xf0,0,0,0,0,0,0,0,0,0,0,0,0,0,0};

__device__ __forceinline__ int tid_opaque() { int t = threadIdx.x; asm volatile("" : "+v"(t)); return t; }
__device__ __forceinline__ int bid_opaque() { int b = blockIdx.x; asm volatile("" : "+s"(b)); return b; }
__device__ __forceinline__ u32x4 zero4() { uint32_t z = 0; asm volatile("" : "+v"(z)); return u32x4{z, z, z, z}; }
__device__ __forceinline__ uint32_t pack_bf16(float a, float b) {
  uint32_t ua = __float_as_uint(a), ub = __float_as_uint(b);
  ua += 0x7FFFu + ((ua >> 16) & 1u);
  ub += 0x7FFFu + ((ub >> 16) & 1u);
  return (ua >> 16) | (ub & 0xFFFF0000u);
}
__device__ __forceinline__ u16 f2bf(float a) {
  uint32_t ua = __float_as_uint(a);
  ua += 0x7FFFu + ((ua >> 16) & 1u);
  return (u16)(ua >> 16);
}
__device__ __forceinline__ float bf2f(u16 h) { return __uint_as_float(((uint32_t)h) << 16); }
__device__ __forceinline__ float bflo(uint32_t w) { return __uint_as_float(w << 16); }
__device__ __forceinline__ float bfhi(uint32_t w) { return __uint_as_float(w & 0xFFFF0000u); }
__device__ __forceinline__ float gelu_exact(float x) { return 0.5f * x * (1.0f + erff(x * 0.70710678118654752f)); }
__device__ __forceinline__ u32x4 cvt8(f32x4 a, f32x4 b) {
  u32x4 o; o.x = pack_bf16(a.x, a.y); o.y = pack_bf16(a.z, a.w); o.z = pack_bf16(b.x, b.y); o.w = pack_bf16(b.z, b.w); return o;
}
__device__ __forceinline__ bf16x8 as_frag(u32x4 v) { union { u32x4 u; bf16x8 f; } c; c.u = v; return c.f; }
__device__ __forceinline__ float wave_sum(float v) {
#pragma unroll
  for (int o = 32; o >= 1; o >>= 1) v += __shfl_xor(v, o);
  return v;
}

__device__ __forceinline__ void stage_half(const u16* __restrict__ base, int ld, unsigned char* dst, int tid) {
#pragma unroll
  for (int i = 0; i < 4; i++) {
    const int b = tid * 16 + i * 4096;
    const int st = b >> 10, sb = b & 1023, swz = sb ^ (((sb >> 9) & 1) << 5);
    const int R = (st >> 1) * 16 + (swz >> 6), C = (st & 1) * 32 + ((swz & 63) >> 1);
    __builtin_amdgcn_global_load_lds((const unsigned*)(base + (size_t)R * ld + C), (unsigned*)(dst + b), 16, 0, 0);
  }
}
#define WAIT_VM(n) asm volatile("s_waitcnt vmcnt(" #n ")" ::: "memory")

__device__ __forceinline__ void gemm128(const u16* __restrict__ A, int lda, const u16* __restrict__ Bt, int ldb, int K,
                                        u16* lds, f32x4 (&acc)[4][4]) {
  const int tid = tid_opaque(), lane = tid & 63, w = tid >> 6;
  const int wm = w >> 1, wn = w & 1, fr = lane & 15, fq = lane >> 4;
#pragma unroll
  for (int i = 0; i < 4; i++)
#pragma unroll
    for (int j = 0; j < 4; j++) acc[i][j] = f32x4{0.f, 0.f, 0.f, 0.f};
  unsigned char* L = (unsigned char*)lds;
  const int nk = K >> 6;
  stage_half(A, lda, L, tid);
  stage_half(Bt, ldb, L + 16384, tid);
  stage_half(A + 64, lda, L + 32768, tid);
  stage_half(Bt + 64, ldb, L + 49152, tid);
  const int laneoff = fr * 64 + ((fq ^ ((fr >> 3) << 1)) << 4);
  const unsigned char* rA = L + wm * 8192 + laneoff;
  const unsigned char* rB = L + 16384 + wn * 8192 + laneoff;
  for (int kt = 0; kt < nk; kt++) {
    const int cur = (kt & 1) * 32768;
    if (kt + 1 < nk) WAIT_VM(8); else WAIT_VM(0);
    __builtin_amdgcn_s_barrier();
    asm volatile("" ::: "memory");
#pragma unroll
    for (int ks = 0; ks < 2; ks++) {
      bf16x8 af[4], bfr[4];
#pragma unroll
      for (int i = 0; i < 4; i++) af[i] = *(const bf16x8*)(rA + cur + (i * 2 + ks) * 1024);
#pragma unroll
      for (int j = 0; j < 4; j++) bfr[j] = *(const bf16x8*)(rB + cur + (j * 2 + ks) * 1024);
#pragma unroll
      for (int i = 0; i < 4; i++)
#pragma unroll
        for (int j = 0; j < 4; j++) acc[i][j] = __builtin_amdgcn_mfma_f32_16x16x32_bf16(af[i], bfr[j], acc[i][j], 0, 0, 0);
    }
    asm volatile("s_waitcnt lgkmcnt(0)" ::: "memory");
    __builtin_amdgcn_s_barrier();
    asm volatile("" ::: "memory");
    if (kt + 2 < nk) {
      stage_half(A + (kt + 2) * 64, lda, L + cur, tid);
      stage_half(Bt + (kt + 2) * 64, ldb, L + cur + 16384, tid);
    }
  }
  __syncthreads();
}

__device__ __forceinline__ void transpose_tile(const float* __restrict__ src, u16* __restrict__ dst, int K, int N, int k0, int n0, float* tl) {
  const int tid = tid_opaque();
#pragma unroll
  for (int i = 0; i < 4; i++) {
    int r = (tid >> 4) + i * 16, c = (tid & 15) * 4;
    f32x4 v = *(const f32x4*)(src + (size_t)(k0 + r) * N + n0 + c);
    tl[r * 65 + c] = v.x; tl[r * 65 + c + 1] = v.y; tl[r * 65 + c + 2] = v.z; tl[r * 65 + c + 3] = v.w;
  }
  __syncthreads();
  const int n = tid >> 2, kc = (tid & 3) * 16;
  uint32_t o[8];
#pragma unroll
  for (int e = 0; e < 8; e++) o[e] = pack_bf16(tl[(kc + 2 * e) * 65 + n], tl[(kc + 2 * e + 1) * 65 + n]);
  u32x4* d = (u32x4*)(dst + (size_t)(n0 + n) * K + k0 + kc);
  d[0] = u32x4{o[0], o[1], o[2], o[3]};
  d[1] = u32x4{o[4], o[5], o[6], o[7]};
  __syncthreads();
}

__device__ __forceinline__ void convert_span(const float* __restrict__ s, u16* __restrict__ d, float* __restrict__ fcopy, size_t n8) {
  const size_t stride = (size_t)gridDim.x * 256;
  for (size_t g0 = (size_t)bid_opaque() * 256 + tid_opaque(); g0 < n8; g0 += stride * 4) {
    f32x4 a[4], b[4];
#pragma unroll
    for (int u = 0; u < 4; u++) {
      const size_t g = g0 + u * stride;
      if (g < n8) { a[u] = ((const f32x4*)s)[2 * g]; b[u] = ((const f32x4*)s)[2 * g + 1]; }
    }
#pragma unroll
    for (int u = 0; u < 4; u++) {
      const size_t g = g0 + u * stride;
      if (g < n8) {
        ((u32x4*)d)[g] = cvt8(a[u], b[u]);
        if (fcopy) { ((f32x4*)fcopy)[2 * g] = a[u]; ((f32x4*)fcopy)[2 * g + 1] = b[u]; }
      }
    }
  }
}
__device__ __forceinline__ void convert_span_fp6(const float* __restrict__ s, unsigned char* __restrict__ d, size_t gbeg, size_t n32, float sc) {
  const size_t stride = (size_t)gridDim.x * 256;
  for (size_t g0 = gbeg + (size_t)bid_opaque() * 256 + tid_opaque(); g0 < n32; g0 += stride * 2) {
    f32x4 a[2][8];
#pragma unroll
    for (int u = 0; u < 2; u++) {
      const size_t g = g0 + u * stride;
      if (g < n32) {
#pragma unroll
        for (int q = 0; q < 8; q++) a[u][q] = __builtin_nontemporal_load(((const f32x4*)s) + 8 * g + q);
      }
    }
#pragma unroll
    for (int u = 0; u < 2; u++) {
      const size_t g = g0 + u * stride;
      if (g < n32) {
        f32x16 lo, hi;
#pragma unroll
        for (int q = 0; q < 4; q++)
#pragma unroll
          for (int e = 0; e < 4; e++) {
            const int idx = q * 4 + e;
            lo[idx] = a[u][idx >> 1][(idx & 1) * 2] * sc; hi[idx] = a[u][idx >> 1][(idx & 1) * 2 + 1] * sc;
          }
        const u32x6 pk = __builtin_amdgcn_cvt_scalef32_2xpk16_fp6_f32(lo, hi, 1.0f);
        u32x2* dp = (u32x2*)(d + (g >> 5) * 1280 + (g & 31) * 24);
        dp[0] = u32x2{pk[0], pk[1]}; dp[1] = u32x2{pk[2], pk[3]}; dp[2] = u32x2{pk[4], pk[5]};
      }
    }
  }
}

__device__ __forceinline__ void convert_span_fp4(const float* __restrict__ s, unsigned char* __restrict__ d, size_t gbeg, size_t n32, float sc) {
  const size_t stride = (size_t)gridDim.x * 256;
  for (size_t g0 = gbeg + (size_t)bid_opaque() * 256 + tid_opaque(); g0 < n32; g0 += stride * 2) {
    f32x4 a[2][8];
#pragma unroll
    for (int u = 0; u < 2; u++) {
      const size_t g = g0 + u * stride;
      if (g < n32) {
#pragma unroll
        for (int q = 0; q < 8; q++) a[u][q] = __builtin_nontemporal_load(((const f32x4*)s) + 8 * g + q);
      }
    }
#pragma unroll
    for (int u = 0; u < 2; u++) {
      const size_t g = g0 + u * stride;
      if (g < n32) {
        u32x4 o;
#pragma unroll
        for (int wd = 0; wd < 4; wd++) {
          unsigned wv = 0;
          wv = __builtin_amdgcn_cvt_scalef32_pk_fp4_f32(wv, a[u][2 * wd].x * sc, a[u][2 * wd].y * sc, 1.0f, 0);
          wv = __builtin_amdgcn_cvt_scalef32_pk_fp4_f32(wv, a[u][2 * wd].z * sc, a[u][2 * wd].w * sc, 1.0f, 1);
          wv = __builtin_amdgcn_cvt_scalef32_pk_fp4_f32(wv, a[u][2 * wd + 1].x * sc, a[u][2 * wd + 1].y * sc, 1.0f, 2);
          wv = __builtin_amdgcn_cvt_scalef32_pk_fp4_f32(wv, a[u][2 * wd + 1].z * sc, a[u][2 * wd + 1].w * sc, 1.0f, 3);
          o[wd] = wv;
        }
        *(u32x4*)(d + (g >> 5) * 1280 + 768 + (g & 31) * 16) = o;
      }
    }
  }
}

__device__ __forceinline__ int xcd_tile(int t, int ntiles) { return (t & 7) * (ntiles >> 3) + (t >> 3); }

__device__ __forceinline__ void convert_tables_part(PP p, int layer, int part) {
  const size_t lo = part == 0 ? 0 : (part == 1 ? 174763 : 349526), hi = part == 0 ? 174763 : (part == 1 ? 349526 : 524288);
  const size_t g0 = (size_t)layer * 524288 + lo;
  convert_span_fp6(p->peer_u, p->ub, g0, g0 + (hi - lo), PEER_SU);
  convert_span_fp4(p->peer_v, p->ub, g0, g0 + (hi - lo), PEER_SV);
}

__device__ __forceinline__ void phase_prologue(PP p, unsigned char* smem) {
  float* tl = (float*)smem;
  for (int t = bid_opaque(); t < 5248; t += gridDim.x) {
    const float* src; u16* dst; int N, tt;
    if (t < 768) { tt = t; N = 1536; src = p->a_w_in; dst = p->wT_a_in; }
    else if (t < 1664) { tt = t - 768; N = 1792; src = p->b_w_in; dst = p->wT_b_in; }
    else if (t < 2176) { tt = t - 1664; N = 512; src = p->w_mem_kv; dst = p->wT_memkv; }
    else if (t < 3200) { tt = t - 2176; N = 1024; src = p->w_out; dst = p->wT_out; }
    else { tt = t - 3200; N = 2048; src = p->peer_w_q; dst = p->wT_pq; }
    const int ntn = N >> 6, per = 16 * ntn;
    const int mat = tt / per, r = tt % per, kt = r / ntn, nt = r % ntn;
    transpose_tile(src + (size_t)mat * 1024 * N, dst + (size_t)mat * 1024 * N, 1024, N, kt * 64, nt * 64, tl);
  }
  convert_span(p->peer_subkeys, p->subk, nullptr, 131072);
  convert_span(p->mem_prompt, p->memb, nullptr, 65536);
  convert_span(p->x_prompt, p->xb, nullptr, 2097152);
  convert_span(p->x_sample, p->xb + (size_t)T_P * 1024, nullptr, 65536);
  for (int idx = bid_opaque() * 256 + tid_opaque(); idx < 8196 * 8; idx += gridDim.x * 256) {
    const int pos = idx >> 3, d = idx & 7;
    const double inv = c_rope_inv[d];
    double ang = (double)pos * inv;
    double n = rint(ang * 0.15915494309189535);
    double r = ang - n * 6.283185307179586476925;
    double r2 = r * r, ts = r, tc = 1.0, ss = r, cc = 1.0;
    for (int k = 0; k < 14; k++) {
      tc = -tc * r2 / (double)((2 * k + 1) * (2 * k + 2));
      ts = -ts * r2 / (double)((2 * k + 2) * (2 * k + 3));
      cc += tc; ss += ts;
    }
    p->ropecs[2 * idx] = (float)cc;
    p->ropecs[2 * idx + 1] = (float)ss;
  }
}

__device__ __forceinline__ void phase_inproj(PP p, int layer, unsigned char* smem) {
  const int jl = layer >> 1;
  const bool isA = !(layer & 1);
  const int NIN = isA ? 1536 : 1792, ntn = NIN >> 7;
  const u16* W = isA ? p->wT_a_in + (size_t)jl * 1536 * 1024 : p->wT_b_in + (size_t)jl * 1792 * 1024;
  const int ntiles = 132 * ntn, extra = (layer == 0) ? 64 : 0;
  const int tid = tid_opaque(), lane = tid & 63, w = tid >> 6, wm = w >> 1, wn = w & 1, quad = lane >> 4, lc = lane & 15;
  for (int t = bid_opaque(); t < ntiles + extra; t += gridDim.x) {
    f32x4 acc[4][4];
    if (t < ntiles) {
      const int tx = xcd_tile(t, ntiles);
      const int tm = tx / ntn, tn = tx % ntn;
      gemm128(p->xb + (size_t)tm * 128 * 1024, 1024, W + (size_t)tn * 128 * 1024, 1024, 1024, (u16*)smem, acc);
      const int rb = tm * 128 + wm * 64, cb = tn * 128 + wn * 64;
      u16* Cs = (u16*)smem;
      if (isA && tn < 8) {
        f32x2 cs[4][4];
#pragma unroll
        for (int i = 0; i < 4; i++)
#pragma unroll
          for (int r = 0; r < 4; r++) {
            const int row = rb + i * 16 + quad * 4 + r;
            const int pos = row < T_P ? (row & 8191) : 8192 + ((row - T_P) & 3);
            cs[i][r] = *(const f32x2*)(p->ropecs + (size_t)(pos * 8 + (lc & 7)) * 2);
          }
#pragma unroll
        for (int i = 0; i < 4; i++)
#pragma unroll
          for (int r = 0; r < 4; r++) {
            const float v = acc[i][0][r];
            const float partner = __shfl_xor(v, 8);
            acc[i][0][r] = (lc < 8) ? (v * cs[i][r].x - partner * cs[i][r].y) : (v * cs[i][r].x + partner * cs[i][r].y);
          }
      }
      if (!isA && tn < 12) {
#pragma unroll
        for (int i = 0; i < 4; i++)
#pragma unroll
          for (int j = 0; j < 4; j++)
#pragma unroll
            for (int r = 0; r < 4; r++) acc[i][j][r] = gelu_exact(acc[i][j][r]);
      }
#pragma unroll
      for (int i = 0; i < 4; i++)
#pragma unroll
        for (int j = 0; j < 4; j++)
#pragma unroll
          for (int r = 0; r < 4; r++) Cs[(wm * 64 + i * 16 + quad * 4 + r) * 136 + wn * 64 + j * 16 + lc] = f2bf(acc[i][j][r]);
      if (isA && tn >= 6 && tn < 10) {
        float* okp = (tn < 8) ? p->swa_k_prompt : p->swa_v_prompt;
        float* oks = (tn < 8) ? p->swa_k_sample : p->swa_v_sample;
        const int cko = (tn < 8) ? 768 : 1024;
#pragma unroll
        for (int i = 0; i < 4; i++)
#pragma unroll
          for (int r = 0; r < 4; r++) {
            const int row = rb + i * 16 + quad * 4 + r;
            float* dst = nullptr;
            if (row < T_P) {
              const int b = row >> 13, s2 = row & 8191;
              if (s2 >= 8064) dst = okp + ((size_t)(jl * 2 + b) * 128 + (s2 - 8064)) * 256;
            } else {
              dst = oks + ((size_t)jl * 512 + (row - T_P)) * 256;
            }
            if (dst) {
#pragma unroll
              for (int j = 0; j < 4; j++) dst[cb + j * 16 + lc - cko] = acc[i][j][r];
            }
          }
      }
      __syncthreads();
#pragma unroll
      for (int it = 0; it < 8; it++) {
        const int row = it * 16 + (tid >> 4), ch = tid & 15;
        *(u32x4*)(p->z + (size_t)(tm * 128 + row) * ZLD + tn * 128 + ch * 8) = *(const u32x4*)(Cs + row * 136 + ch * 8);
      }
      __syncthreads();
    } else {
      const int t2 = t - ntiles, l = t2 >> 4, tm = (t2 >> 2) & 3, tn = t2 & 3;
      gemm128(p->memb + (size_t)tm * 128 * 1024, 1024, p->wT_memkv + ((size_t)l * 512 + tn * 128) * 1024, 1024, 1024, (u16*)smem, acc);
      const int rb = tm * 128 + wm * 64, cb = tn * 128 + wn * 64;
#pragma unroll
      for (int i = 0; i < 4; i++)
#pragma unroll
        for (int j = 0; j < 4; j++)
#pragma unroll
          for (int r = 0; r < 4; r++) {
            const int row = rb + i * 16 + quad * 4 + r, col = cb + j * 16 + lc;
            const float v = acc[i][j][r];
            const int kv = col >> 8, c2 = col & 255;
            float* o = kv ? p->mem_v_prompt : p->mem_k_prompt;
            o[((size_t)l * 512 + row) * 256 + c2] = v;
            p->mkvp[((size_t)(l * 2 + kv) * 512 + row) * 256 + c2] = f2bf(v);
          }
    }
  }
  convert_tables_part(p, layer, 0);
}

template <int NK, bool SINK, int NSUB, class FK, class FV, class FQ, class FM, class FS, class FO>
__device__ __forceinline__ void attn_core(u16* lds, int nrows, FK loadK, FV loadV, FQ loadQ, FM allowed, FS sinkf, FO outp) {
  const int tid = tid_opaque(), lane = tid & 63, w = tid >> 6, quad = lane >> 4, lc = lane & 15;
  u16* Ks = lds;
  u16* Vt = lds + 256 * 72;
  {
    constexpr int NIT = NK * 8 / 256;
    u32x4 kreg[NIT], vreg[NIT];
#pragma unroll
    for (int it = 0; it < NIT; it++) {
      const int c = tid + it * 256, kk = c >> 3, ch = c & 7;
      kreg[it] = loadK(kk, ch);
      vreg[it] = loadV(kk, ch);
    }
#pragma unroll
    for (int it = 0; it < NIT; it++) {
      const int c = tid + it * 256, kk = c >> 3, ch = c & 7;
      *(u32x4*)(Ks + kk * 72 + ch * 8) = kreg[it];
      const u32x4 vv = vreg[it];
      u16* vd = Vt + (ch * 8) * 264 + kk;
      vd[0 * 264] = (u16)(vv.x & 0xFFFF); vd[1 * 264] = (u16)(vv.x >> 16);
      vd[2 * 264] = (u16)(vv.y & 0xFFFF); vd[3 * 264] = (u16)(vv.y >> 16);
      vd[4 * 264] = (u16)(vv.z & 0xFFFF); vd[5 * 264] = (u16)(vv.z >> 16);
      vd[6 * 264] = (u16)(vv.w & 0xFFFF); vd[7 * 264] = (u16)(vv.w >> 16);
    }
  }
  __syncthreads();
  const bool active = (w * 16 < nrows);
  constexpr int NT = NK / 16;
  if (active) {
    const int row = w * 16 + lc;
    bf16x8 qn0 = as_frag(loadQ(0, row, quad * 8)), qn1 = as_frag(loadQ(0, row, 32 + quad * 8));
#pragma unroll 1
    for (int sub = 0; sub < NSUB; sub++) {
      bf16x8 qf[1][2];
      qf[0][0] = qn0; qf[0][1] = qn1;
      if (sub + 1 < NSUB) { qn0 = as_frag(loadQ(sub + 1, row, quad * 8)); qn1 = as_frag(loadQ(sub + 1, row, 32 + quad * 8)); }
      f32x4 s[NT];
#pragma unroll
      for (int nt = 0; nt < NT; nt++) {
        s[nt] = f32x4{0.f, 0.f, 0.f, 0.f};
#pragma unroll
        for (int ks = 0; ks < 2; ks++) {
          const bf16x8 kf = *(const bf16x8*)(Ks + (nt * 16 + lc) * 72 + ks * 32 + quad * 8);
          s[nt] = __builtin_amdgcn_mfma_f32_16x16x32_bf16(kf, qf[0][ks], s[nt], 0, 0, 0);
        }
      }
      __builtin_amdgcn_sched_barrier(0);
      const float sk = SINK ? sinkf(sub, row) : -3.0e38f;
      float m = sk;
#pragma unroll
      for (int nt = 0; nt < NT; nt++)
#pragma unroll
        for (int r = 0; r < 4; r++) {
          const float v = allowed(sub, row, nt * 16 + quad * 4 + r) ? s[nt][r] * 0.125f : -1.0e30f;
          s[nt][r] = v;
          m = fmaxf(m, v);
        }
      m = fmaxf(m, __shfl_xor(m, 16)); m = fmaxf(m, __shfl_xor(m, 32));
      float sum = 0.f;
#pragma unroll
      for (int nt = 0; nt < NT; nt++)
#pragma unroll
        for (int r = 0; r < 4; r++) { const float e = __expf(s[nt][r] - m); s[nt][r] = e; sum += e; }
      sum += __shfl_xor(sum, 16); sum += __shfl_xor(sum, 32);
      if (SINK) sum += __expf(sk - m);
      const float inv = 1.0f / sum;
      __builtin_amdgcn_sched_barrier(0);
      f32x4 o[4];
#pragma unroll
      for (int dt = 0; dt < 4; dt++) o[dt] = f32x4{0.f, 0.f, 0.f, 0.f};
#pragma unroll
      for (int kk = 0; kk < NT / 2; kk++) {
        u32x4 pp;
        pp.x = pack_bf16(s[2 * kk][0] * inv, s[2 * kk][1] * inv); pp.y = pack_bf16(s[2 * kk][2] * inv, s[2 * kk][3] * inv);
        pp.z = pack_bf16(s[2 * kk + 1][0] * inv, s[2 * kk + 1][1] * inv); pp.w = pack_bf16(s[2 * kk + 1][2] * inv, s[2 * kk + 1][3] * inv);
        const bf16x8 pf = as_frag(pp);
#pragma unroll
        for (int dt = 0; dt < 4; dt++) {
          const u16* vr = Vt + (dt * 16 + lc) * 264 + kk * 32 + quad * 4;
          const u32x2 v0 = *(const u32x2*)vr, v1 = *(const u32x2*)(vr + 16);
          const bf16x8 vf = as_frag(u32x4{v0.x, v0.y, v1.x, v1.y});
          o[dt] = __builtin_amdgcn_mfma_f32_16x16x32_bf16(vf, pf, o[dt], 0, 0, 0);
        }
        __builtin_amdgcn_sched_barrier(0);
      }
      if (row < nrows) {
        u16* op = outp(sub, row);
#pragma unroll
        for (int dt = 0; dt < 4; dt++)
          *(u32x2*)(op + dt * 16 + quad * 4) = u32x2{pack_bf16(o[dt][0], o[dt][1]), pack_bf16(o[dt][2], o[dt][3])};
      }
    }
  }
  __syncthreads();
}

__device__ __forceinline__ u32x4 ld_f32x8_as_bf16(const float* ptr) {
  const f32x4 a = *(const f32x4*)ptr, b = *(const f32x4*)(ptr + 4);
  return cvt8(a, b);
}

__device__ __forceinline__ void sg_prompt_item(PP p, int jl, int item, unsigned char* smem) {
  const int tid = tid_opaque(), lane = tid & 63, w = tid >> 6, quad = lane >> 4, lc = lane & 15;
  float* stats = (float*)smem;
  float* lnp = (float*)(smem + 1024);
  u16* Vt = (u16*)(smem + 2560);
  const int tok0 = (item >> 2) * 128;
  const int g = item & 3;
  for (int bt = 0; bt < 4; bt++) {
    const int srow = w * 32 + bt * 8 + (lane >> 3);
    const u16* zr = p->z + (size_t)(tok0 + srow) * ZLD + 768 + (lane & 7) * 96;
    u32x4 q[12];
#pragma unroll
    for (int i = 0; i < 12; i++) q[i] = *(const u32x4*)(zr + i * 8);
    float sum = 0.f;
#pragma unroll
    for (int i = 0; i < 12; i++)
#pragma unroll
      for (int e = 0; e < 4; e++) sum += bflo(q[i][e]) + bfhi(q[i][e]);
    sum += __shfl_xor(sum, 1); sum += __shfl_xor(sum, 2); sum += __shfl_xor(sum, 4);
    const float mu = sum * (1.0f / 768.0f);
    float sq = 0.f;
#pragma unroll
    for (int i = 0; i < 12; i++)
#pragma unroll
      for (int e = 0; e < 4; e++) { const float d0 = bflo(q[i][e]) - mu, d1 = bfhi(q[i][e]) - mu; sq += d0 * d0 + d1 * d1; }
    sq += __shfl_xor(sq, 1); sq += __shfl_xor(sq, 2); sq += __shfl_xor(sq, 4);
    if ((lane & 7) == 0) { stats[srow * 2] = mu; stats[srow * 2 + 1] = rsqrtf(sq * (1.0f / 768.0f) + LN_EPS_F); }
  }
  if (tid < 192) { lnp[tid * 2] = p->b_v_ln_g[jl * 768 + g * 192 + tid]; lnp[tid * 2 + 1] = p->b_v_ln_b[jl * 768 + g * 192 + tid]; }
  __syncthreads();
  {
    {
      u32x4 q[12];
#pragma unroll
      for (int it = 0; it < 12; it++) {
        const int c2 = tid + it * 256, s2 = c2 / 24, ch = c2 % 24;
        q[it] = *(const u32x4*)(p->z + (size_t)(tok0 + s2) * ZLD + 768 + g * 192 + ch * 8);
      }
#pragma unroll
      for (int it = 0; it < 12; it++) {
        const int c2 = tid + it * 256, s2 = c2 / 24, ch = c2 % 24;
        const float mu = stats[s2 * 2], rs = stats[s2 * 2 + 1];
        const float* lp = lnp + ch * 16;
        u16* vd = Vt + (ch * 8) * 136 + s2;
#pragma unroll
        for (int e = 0; e < 4; e++) {
          vd[(2 * e) * 136] = f2bf((bflo(q[it][e]) - mu) * rs * lp[4 * e] + lp[4 * e + 1]);
          vd[(2 * e + 1) * 136] = f2bf((bfhi(q[it][e]) - mu) * rs * lp[4 * e + 2] + lp[4 * e + 3]);
        }
      }
    }
    __syncthreads();
    const float* wsg = p->b_w_s + (size_t)(jl * 4 + g) * 128 * 128;
    const float* bsg = p->b_b_s + (jl * 4 + g) * 128;
    for (int hh = 0; hh < 2; hh++) {
      f32x4 acc[2][6];
#pragma unroll
      for (int i = 0; i < 2; i++)
#pragma unroll
        for (int jt = 0; jt < 6; jt++) acc[i][jt] = f32x4{0.f, 0.f, 0.f, 0.f};
#pragma unroll
      for (int i = 0; i < 2; i++) {
        const int R = w * 32 + i * 16;
#pragma unroll
        for (int ks = 0; ks < 4; ks++) {
          if (ks * 32 <= R + 15) {
            const int t = R + lc, s0 = ks * 32 + quad * 8;
            const f32x4 a0 = *(const f32x4*)(wsg + t * 128 + s0), a1 = *(const f32x4*)(wsg + t * 128 + s0 + 4);
            float av[8] = {a0.x, a0.y, a0.z, a0.w, a1.x, a1.y, a1.z, a1.w};
#pragma unroll
            for (int e = 0; e < 8; e++) av[e] = (s0 + e <= t) ? av[e] : 0.f;
            u32x4 au; au.x = pack_bf16(av[0], av[1]); au.y = pack_bf16(av[2], av[3]); au.z = pack_bf16(av[4], av[5]); au.w = pack_bf16(av[6], av[7]);
            const bf16x8 a = as_frag(au);
#pragma unroll
            for (int jt = 0; jt < 6; jt++) {
              const bf16x8 b = *(const bf16x8*)(Vt + ((hh * 6 + jt) * 16 + lc) * 136 + ks * 32 + quad * 8);
              acc[i][jt] = __builtin_amdgcn_mfma_f32_16x16x32_bf16(a, b, acc[i][jt], 0, 0, 0);
            }
          }
        }
      }
#pragma unroll
      for (int i = 0; i < 2; i++) {
        float bs[4];
        u16 zu[4][6];
#pragma unroll
        for (int r = 0; r < 4; r++) {
          const int t = w * 32 + i * 16 + quad * 4 + r;
          bs[r] = bsg[t];
          const u16* zp = p->z + (size_t)(tok0 + t) * ZLD + g * 192 + hh * 96;
#pragma unroll
          for (int jt = 0; jt < 6; jt++) zu[r][jt] = zp[jt * 16 + lc];
        }
#pragma unroll
        for (int r = 0; r < 4; r++) {
          const int t = w * 32 + i * 16 + quad * 4 + r;
          u16* mo = p->mix + (size_t)(tok0 + t) * 1024 + g * 192 + hh * 96;
#pragma unroll
          for (int jt = 0; jt < 6; jt++) mo[jt * 16 + lc] = f2bf(bf2f(zu[r][jt]) * (acc[i][jt][r] + bs[r]));
        }
      }
    }
    __syncthreads();
  }
}

__device__ __forceinline__ void sg_sample_item(PP p, int jl, int b, unsigned char* smem) {
  const int tid = tid_opaque(), lane = tid & 63, w = tid >> 6;
  float* vln = (float*)smem;
  {
    const int tok = T_P + b * 4 + w;
    const u16* zr = p->z + (size_t)tok * ZLD + 768;
    float v[12];
#pragma unroll
    for (int i = 0; i < 3; i++) {
      const u32x2 q = *(const u32x2*)(zr + i * 256 + lane * 4);
      v[i * 4 + 0] = bflo(q.x); v[i * 4 + 1] = bfhi(q.x); v[i * 4 + 2] = bflo(q.y); v[i * 4 + 3] = bfhi(q.y);
    }
    float sum = 0.f;
#pragma unroll
    for (int i = 0; i < 12; i++) sum += v[i];
    const float mu = wave_sum(sum) * (1.0f / 768.0f);
    float sq = 0.f;
#pragma unroll
    for (int i = 0; i < 12; i++) { const float d = v[i] - mu; sq += d * d; }
    const float rs = rsqrtf(wave_sum(sq) * (1.0f / 768.0f) + LN_EPS_F);
    float* og = p->sg_v_sample + ((size_t)(jl * 128 + b) * 4 + w) * 768;
    f32x4 lg[3], lb[3];
#pragma unroll
    for (int i = 0; i < 3; i++) { lg[i] = *(const f32x4*)(p->b_v_ln_g + jl * 768 + i * 256 + lane * 4); lb[i] = *(const f32x4*)(p->b_v_ln_b + jl * 768 + i * 256 + lane * 4); }
#pragma unroll
    for (int i = 0; i < 3; i++) {
      f32x4 o;
      o.x = (v[i * 4 + 0] - mu) * rs * lg[i].x + lb[i].x; o.y = (v[i * 4 + 1] - mu) * rs * lg[i].y + lb[i].y;
      o.z = (v[i * 4 + 2] - mu) * rs * lg[i].z + lb[i].z; o.w = (v[i * 4 + 3] - mu) * rs * lg[i].w + lb[i].w;
      *(f32x4*)(vln + w * 768 + i * 256 + lane * 4) = o;
      *(f32x4*)(og + i * 256 + lane * 4) = o;
    }
  }
  __syncthreads();
  {
    float wv[3][10], bsv[3][4], zu[3][4];
#pragma unroll
    for (int k = 0; k < 3; k++) {
      const int c = tid + k * 256, g = c / 192;
      const float* wsg = p->b_w_s + (size_t)(jl * 4 + g) * 128 * 128;
      const float* bsg = p->b_b_s + (jl * 4 + g) * 128;
      int n = 0;
#pragma unroll
      for (int t = 0; t < 4; t++) {
        bsv[k][t] = bsg[t];
        zu[k][t] = bf2f(p->z[(size_t)(T_P + b * 4 + t) * ZLD + c]);
#pragma unroll
        for (int s2 = 0; s2 <= t; s2++) wv[k][n++] = wsg[t * 128 + s2];
      }
    }
#pragma unroll
    for (int k = 0; k < 3; k++) {
      const int c = tid + k * 256;
      int n = 0;
#pragma unroll
      for (int t = 0; t < 4; t++) {
        float sg = bsv[k][t];
#pragma unroll
        for (int s2 = 0; s2 <= t; s2++) sg += wv[k][n++] * vln[s2 * 768 + c];
        p->mix[(size_t)(T_P + b * 4 + t) * 1024 + c] = f2bf(zu[k][t] * sg);
      }
    }
  }
  __syncthreads();
}

__device__ __forceinline__ void mem_prompt_item(PP p, int layer, int it, unsigned char* smem) {
  const int qoff = (layer & 1) ? 1536 : 1280;
  const int mh = it & 3, tp = it >> 2;
  const int tok0 = tp * 128, b = tok0 >> 13;
  const u16* kb = p->mkvp + ((size_t)(layer * 2 + 0) * 512 + b * 256) * 256 + mh * 64;
  const u16* vb = p->mkvp + ((size_t)(layer * 2 + 1) * 512 + b * 256) * 256 + mh * 64;
  const u16* qb = p->z + (size_t)tok0 * ZLD + qoff + mh * 64;
  u16* ob = p->mix + (size_t)tok0 * 1024 + 768 + mh * 64;
  attn_core<256, false, 2>((u16*)smem, 64,
      [&](int kk, int ch) { return *(const u32x4*)(kb + (size_t)kk * 256 + ch * 8); },
      [&](int kk, int ch) { return *(const u32x4*)(vb + (size_t)kk * 256 + ch * 8); },
      [&](int sub, int row, int ko) { return *(const u32x4*)(qb + (size_t)(sub * 64 + row) * ZLD + ko); },
      [&](int, int, int) { return true; },
      [&](int, int) { return 0.f; },
      [&](int sub, int row) { return ob + (size_t)(sub * 64 + row) * 1024; });
}

__device__ __forceinline__ void mem_sample_item(PP p, int layer, int it, unsigned char* smem) {
  const int qoff = (layer & 1) ? 1536 : 1280;
  const int mh = it & 3, b = it >> 2;
  const float* kb = p->cache_mem_k + ((size_t)(layer * 128 + b) * 256) * 256 + mh * 64;
  const float* vb = p->cache_mem_v + ((size_t)(layer * 128 + b) * 256) * 256 + mh * 64;
  const int tok0 = T_P + b * 4;
  const u16* qb = p->z + (size_t)tok0 * ZLD + qoff + mh * 64;
  u16* ob = p->mix + (size_t)tok0 * 1024 + 768 + mh * 64;
  attn_core<256, false, 1>((u16*)smem, 4,
      [&](int kk, int ch) { return ld_f32x8_as_bf16(kb + (size_t)kk * 256 + ch * 8); },
      [&](int kk, int ch) { return ld_f32x8_as_bf16(vb + (size_t)kk * 256 + ch * 8); },
      [&](int, int row, int ko) { return row < 4 ? *(const u32x4*)(qb + (size_t)row * ZLD + ko) : zero4(); },
      [&](int, int, int) { return true; },
      [&](int, int) { return 0.f; },
      [&](int, int row) { return ob + (size_t)row * 1024; });
}

__device__ __forceinline__ void swa_prompt_item(PP p, int jl, int it, unsigned char* smem) {
  const int kvh = it & 3, hb = it >> 2;
  const int tok0 = hb * 64, b = tok0 >> 13, q0 = tok0 & 8191;
  const u16* zb = p->z + (size_t)(b * 8192) * ZLD;
  const u16* qb = p->z + (size_t)tok0 * ZLD + kvh * 192;
  u16* ob = p->mix + (size_t)tok0 * 1024 + kvh * 192;
  const float sk0 = p->a_sink[jl * 12 + kvh * 3], sk1 = p->a_sink[jl * 12 + kvh * 3 + 1], sk2 = p->a_sink[jl * 12 + kvh * 3 + 2];
  attn_core<192, true, 3>((u16*)smem, 64,
      [&](int kk, int ch) { const int kp = q0 - 128 + kk; return kp >= 0 ? *(const u32x4*)(zb + (size_t)kp * ZLD + 768 + kvh * 64 + ch * 8) : zero4(); },
      [&](int kk, int ch) { const int kp = q0 - 128 + kk; return kp >= 0 ? *(const u32x4*)(zb + (size_t)kp * ZLD + 1024 + kvh * 64 + ch * 8) : zero4(); },
      [&](int sub, int row, int ko) { return *(const u32x4*)(qb + (size_t)row * ZLD + sub * 64 + ko); },
      [&](int, int row, int kk) { const int qp = q0 + row, kp = q0 - 128 + kk; return kp >= 0 && kp <= qp && qp - kp < 128; },
      [&](int sub, int) { return sub == 0 ? sk0 : (sub == 1 ? sk1 : sk2); },
      [&](int sub, int row) { return ob + (size_t)row * 1024 + sub * 64; });
}

__device__ __forceinline__ void swa_sample_item(PP p, int jl, int it, unsigned char* smem) {
  const int kvh = it & 3, b = it >> 2;
  const float* ck = p->cache_swa_k + ((size_t)(jl * 128 + b) * 128) * 256 + kvh * 64;
  const float* cv = p->cache_swa_v + ((size_t)(jl * 128 + b) * 128) * 256 + kvh * 64;
  const int tok0 = T_P + b * 4;
  const u16* zb = p->z + (size_t)tok0 * ZLD;
  u16* ob = p->mix + (size_t)tok0 * 1024;
  const float* sk = p->a_sink + jl * 12 + kvh * 3;
  attn_core<160, true, 1>((u16*)smem, 12,
      [&](int kk, int ch) {
        if (kk < 128) return ld_f32x8_as_bf16(ck + (size_t)kk * 256 + ch * 8);
        if (kk < 132) return *(const u32x4*)(zb + (size_t)(kk - 128) * ZLD + 768 + kvh * 64 + ch * 8);
        return zero4(); },
      [&](int kk, int ch) {
        if (kk < 128) return ld_f32x8_as_bf16(cv + (size_t)kk * 256 + ch * 8);
        if (kk < 132) return *(const u32x4*)(zb + (size_t)(kk - 128) * ZLD + 1024 + kvh * 64 + ch * 8);
        return zero4(); },
      [&](int, int row, int ko) { return row < 12 ? *(const u32x4*)(zb + (size_t)(row / 3) * ZLD + (kvh * 3 + row % 3) * 64 + ko) : zero4(); },
      [&](int, int row, int kk) { const int t = row / 3; return kk < 128 ? (kk > t) : (kk < 132 && (kk - 128) <= t); },
      [&](int, int row) { return row < 12 ? sk[row % 3] : 0.f; },
      [&](int, int row) { return ob + (size_t)(row / 3) * 1024 + (kvh * 3 + row % 3) * 64; });
}

__device__ __forceinline__ void phase_mixer(PP p, int layer, unsigned char* smem) {
  const int jl = layer >> 1;
  if (!(layer & 1)) {
    for (int it = bid_opaque(); it < 2560; it += gridDim.x) {
      if (it < 1024) swa_prompt_item(p, jl, it, smem);
      else if (it < 1536) mem_prompt_item(p, layer, it - 1024, smem);
      else if (it < 2048) swa_sample_item(p, jl, it - 1536, smem);
      else mem_sample_item(p, layer, it - 2048, smem);
    }
  } else {
    for (int it = bid_opaque(); it < 1664; it += gridDim.x) {
      if (it < 512) sg_prompt_item(p, jl, it, smem);
      else if (it < 1024) mem_prompt_item(p, layer, it - 512, smem);
      else if (it < 1152) sg_sample_item(p, jl, it - 1024, smem);
      else mem_sample_item(p, layer, it - 1152, smem);
    }
  }
}

__device__ __forceinline__ void phase_outproj(PP p, int layer, unsigned char* smem) {
  const int tid = tid_opaque(), lane = tid & 63, w = tid >> 6, wm = w >> 1, wn = w & 1, quad = lane >> 4, lc = lane & 15;
  const u16* W = p->wT_out + (size_t)layer * 1024 * 1024;
  for (int t = bid_opaque(); t < 132 * 8; t += gridDim.x) {
    const int tx = xcd_tile(t, 132 * 8);
    const int tm = tx >> 3, tn = tx & 7;
    f32x4 acc[4][4];
    gemm128(p->mix + (size_t)tm * 128 * 1024, 1024, W + (size_t)tn * 128 * 1024, 1024, 1024, (u16*)smem, acc);
    float* Cs = (float*)smem;
#pragma unroll
    for (int i = 0; i < 4; i++)
#pragma unroll
      for (int j = 0; j < 4; j++)
#pragma unroll
        for (int r = 0; r < 4; r++) Cs[(wm * 64 + i * 16 + quad * 4 + r) * 132 + wn * 64 + j * 16 + lc] = acc[i][j][r];
    __syncthreads();
    const size_t gbase = (size_t)(tm * 128) * 1024 + tn * 128 + (tid & 31) * 4;
#pragma unroll
    for (int hb = 0; hb < 2; hb++) {
      u32x2 res[8];
#pragma unroll
      for (int it = 0; it < 8; it++) res[it] = *(const u32x2*)(p->xb + gbase + (size_t)((hb * 8 + it) * 8 + (tid >> 5)) * 1024);
#pragma unroll
      for (int it = 0; it < 8; it++) {
        const int row = (hb * 8 + it) * 8 + (tid >> 5);
        const f32x4 c = *(const f32x4*)(Cs + row * 132 + (tid & 31) * 4);
        const f32x4 xr = {bflo(res[it].x), bfhi(res[it].x), bflo(res[it].y), bfhi(res[it].y)};
        const f32x4 v = DN_ALPHA_F * xr + c;
        *(u32x2*)(p->preb + gbase + (size_t)row * 1024) = u32x2{pack_bf16(v.x, v.y), pack_bf16(v.z, v.w)};
      }
    }
    __syncthreads();
  }
  convert_tables_part(p, layer, 1);
}

__device__ __forceinline__ void phase_ln1(PP p, int layer) {
  const int tid = tid_opaque(), lane = tid & 63, w = tid >> 6;
  const float* g = p->ln1_g + layer * 1024 + lane * 16;
  const float* bb = p->ln1_b + layer * 1024 + lane * 16;
  for (int tok = bid_opaque() * 4 + w; tok < T_ALL; tok += gridDim.x * 4) {
    const u32x4* pr = (const u32x4*)(p->preb + (size_t)tok * 1024 + lane * 16);
    const u32x4 q0 = pr[0], q1 = pr[1];
    f32x4 gg[4], bv[4];
#pragma unroll
    for (int i = 0; i < 4; i++) { gg[i] = *(const f32x4*)(g + i * 4); bv[i] = *(const f32x4*)(bb + i * 4); }
    float v[16];
#pragma unroll
    for (int e = 0; e < 4; e++) { v[2 * e] = bflo(q0[e]); v[2 * e + 1] = bfhi(q0[e]); v[8 + 2 * e] = bflo(q1[e]); v[8 + 2 * e + 1] = bfhi(q1[e]); }
    float sum = 0.f;
#pragma unroll
    for (int i = 0; i < 16; i++) sum += v[i];
    const float mu = wave_sum(sum) * (1.0f / 1024.0f);
    float sq = 0.f;
#pragma unroll
    for (int i = 0; i < 16; i++) { const float d = v[i] - mu; sq += d * d; }
    const float rs = rsqrtf(wave_sum(sq) * (1.0f / 1024.0f) + LN_EPS_F);
    f32x4 o[4];
#pragma unroll
    for (int i = 0; i < 4; i++) {
      o[i].x = (v[i * 4] - mu) * rs * gg[i].x + bv[i].x; o[i].y = (v[i * 4 + 1] - mu) * rs * gg[i].y + bv[i].y;
      o[i].z = (v[i * 4 + 2] - mu) * rs * gg[i].z + bv[i].z; o[i].w = (v[i * 4 + 3] - mu) * rs * gg[i].w + bv[i].w;
    }
    u32x4* xo = (u32x4*)(p->xb + (size_t)tok * 1024 + lane * 16);
    xo[0] = cvt8(o[0], o[1]);
    xo[1] = cvt8(o[2], o[3]);
  }
}

__device__ __forceinline__ void phase_peerq(PP p, int layer, unsigned char* smem) {
  const int tid = tid_opaque(), lane = tid & 63, w = tid >> 6, wm = w >> 1, wn = w & 1, quad = lane >> 4, lc = lane & 15;
  const u16* W = p->wT_pq + (size_t)layer * 2048 * 1024;
  const float* bq = p->peer_b_q + layer * 2048;
  u16* Qs = (u16*)smem;
  uint32_t* Sk = (uint32_t*)smem;
  for (int t = bid_opaque(); t < 132 * 16; t += gridDim.x) {
    const int tx = xcd_tile(t, 132 * 16);
    const int tm = tx >> 4, tn = tx & 15;
    f32x4 acc[4][4];
    gemm128(p->xb + (size_t)tm * 128 * 1024, 1024, W + (size_t)tn * 128 * 1024, 1024, 1024, (u16*)smem, acc);
    const u16* sk = p->subk + ((size_t)layer * 16 + tn) * 128 * 128;
    unsigned char* Lsk = smem + 36864;
    stage_half(sk, 128, Lsk, tid);
    stage_half(sk + 64, 128, Lsk + 16384, tid);
#pragma unroll
    for (int i = 0; i < 4; i++)
#pragma unroll
      for (int j = 0; j < 4; j++) {
        const int col = wn * 64 + j * 16 + lc;
        const float bias = bq[tn * 128 + col];
#pragma unroll
        for (int r = 0; r < 4; r++) Qs[(wm * 64 + i * 16 + quad * 4 + r) * 136 + col] = f2bf(acc[i][j][r] + bias);
      }
    WAIT_VM(0);
    __syncthreads();
    const unsigned char* rSk = Lsk + wn * 8192 + lc * 64 + ((quad ^ ((lc >> 3) << 1)) << 4);
#pragma unroll
    for (int i = 0; i < 4; i++)
#pragma unroll
      for (int j = 0; j < 4; j++) acc[i][j] = f32x4{0.f, 0.f, 0.f, 0.f};
#pragma unroll
    for (int ks = 0; ks < 4; ks++) {
      bf16x8 af[4], bfr[4];
#pragma unroll
      for (int i = 0; i < 4; i++) af[i] = *(const bf16x8*)(Qs + (wm * 64 + i * 16 + lc) * 136 + ks * 32 + quad * 8);
#pragma unroll
      for (int j = 0; j < 4; j++) bfr[j] = *(const bf16x8*)(rSk + (ks >> 1) * 16384 + (j * 2 + (ks & 1)) * 1024);
#pragma unroll
      for (int i = 0; i < 4; i++)
#pragma unroll
        for (int j = 0; j < 4; j++) acc[i][j] = __builtin_amdgcn_mfma_f32_16x16x32_bf16(af[i], bfr[j], acc[i][j], 0, 0, 0);
    }
    __syncthreads();
#pragma unroll
    for (int i = 0; i < 4; i++)
#pragma unroll
      for (int j = 0; j < 4; j++) {
        const int n = wn * 64 + j * 16 + lc;
#pragma unroll
        for (int r = 0; r < 4; r++) {
          const uint32_t u = __float_as_uint(acc[i][j][r]);
          const uint32_t m = (u & 0x80000000u) ? ~u : (u | 0x80000000u);
          Sk[(wm * 64 + i * 16 + quad * 4 + r) * 129 + n] = (m & ~127u) | (uint32_t)(127 - n);
        }
      }
    __syncthreads();
    if (tid < 128) {
      uint32_t k[128];
#pragma unroll
      for (int e = 0; e < 128; e++) k[e] = Sk[tid * 129 + e];
#pragma unroll
      for (int size = 2; size <= 16; size <<= 1) {
#pragma unroll
        for (int stride = size >> 1; stride > 0; stride >>= 1) {
#pragma unroll
          for (int i = 0; i < 128; i++) {
            const int j = i ^ stride;
            if (j > i) {
              const uint32_t mx = k[i] > k[j] ? k[i] : k[j], mn = k[i] > k[j] ? k[j] : k[i];
              if ((i & size) == 0) { k[i] = mx; k[j] = mn; } else { k[i] = mn; k[j] = mx; }
            }
          }
        }
      }
#pragma unroll
      for (int ng = 4; ng >= 1; ng >>= 1) {
#pragma unroll
        for (int m = 0; m < ng; m++) {
#pragma unroll
          for (int i = 0; i < 16; i++) {
            const uint32_t a = k[(2 * m) * 16 + i], b = k[(2 * m + 1) * 16 + i];
            k[m * 16 + i] = a > b ? a : b;
          }
        }
#pragma unroll
        for (int stride = 8; stride > 0; stride >>= 1) {
#pragma unroll
          for (int i = 0; i < 16 * ng; i++) {
            const int j = i ^ stride;
            if (j > i) {
              const uint32_t mx = k[i] > k[j] ? k[i] : k[j], mn = k[i] > k[j] ? k[j] : k[i];
              if ((i & 16) == 0) { k[i] = mx; k[j] = mn; } else { k[i] = mn; k[j] = mx; }
            }
          }
        }
      }
      u32x4* o = (u32x4*)(p->topk + ((size_t)(tm * 128 + tid) * 16 + tn) * 16);
#pragma unroll
      for (int q = 0; q < 4; q++) {
        u32x4 v;
#pragma unroll
        for (int e = 0; e < 4; e++) { const uint32_t b = k[q * 4 + e]; v[e] = (b & ~127u) | (127u - (b & 127u)); }
        o[q] = v;
      }
    }
    __syncthreads();
  }
  convert_tables_part(p, layer, 2);
}

__device__ __forceinline__ float dec_key(uint32_t key) {
  const uint32_t m = key & ~127u;
  return __uint_as_float((m & 0x80000000u) ? (m ^ 0x80000000u) : ~m);
}

__device__ __forceinline__ void phase_gather(PP p, int layer, unsigned char* smem) {
  const int tid = tid_opaque(), lane = tid & 63, w = tid >> 6;
  const int hl = lane & 31;
  const bool hi_half = lane >= 32;
  const unsigned char* ubl = p->ub + (size_t)layer * 16384 * 1280 + hl * 24;
  const unsigned char* vbl = p->ub + (size_t)layer * 16384 * 1280 + 768 + hl * 16;
  const float* g2 = p->ln2_g + layer * 1024;
  const float* b2 = p->ln2_b + layer * 1024;
  const int ci = c_cand[lane] >> 4, cj = c_cand[lane] & 15;
  float* xo = p->y_out;
  u32x2* selw = (u32x2*)smem + w * 512 + lane;
  for (int tok = bid_opaque() * 4 + w; tok < T_ALL; tok += gridDim.x * 4) {
    f32x32 x, y;
    {
      const u32x4* xr = (const u32x4*)(p->xb + (size_t)tok * 1024 + hl * 32);
#pragma unroll
      for (int i = 0; i < 4; i++) {
        const u32x4 a = xr[i];
#pragma unroll
        for (int e = 0; e < 4; e++) { x[i * 8 + 2 * e] = bflo(a[e]); x[i * 8 + 2 * e + 1] = bfhi(a[e]); }
      }
    }
#pragma unroll
    for (int i = 0; i < 32; i++) y[i] = 0.f;
    u32x2 wu[8][3];
    u32x4 wv[8];
    int e[16];
    uint32_t k0n = p->topk[(size_t)tok * 256 + ci], k1n = p->topk[(size_t)tok * 256 + 16 + cj];
    for (int h = 0; h < 8; h++) {
      const uint32_t k0 = k0n, k1 = k1n;
      if (h + 1 < 8) { const uint32_t* tk = p->topk + ((size_t)tok * 16 + (h + 1) * 2) * 16; k0n = tk[ci]; k1n = tk[16 + cj]; }
      float cand = dec_key(k0) + dec_key(k1);
      int eid = (int)((k0 & 127u) * 128u + (k1 & 127u));
      uint32_t ckey;
      {
        const uint32_t u = __float_as_uint(cand);
        const uint32_t m = (u & 0x80000000u) ? ~u : (u | 0x80000000u);
        ckey = (lane < 50) ? ((m & ~63u) | (uint32_t)(63 - lane)) : 0u;
      }
      int rank = 0;
#pragma unroll
      for (int l2 = 0; l2 < 50; l2++) {
        const uint32_t o = (uint32_t)__builtin_amdgcn_readlane((int)ckey, l2);
        rank += (o > ckey) ? 1 : 0;
      }
      const int dst = (rank < 16) ? ((rank & 1) * 32 + (rank >> 1) * 4) : 1;
      const float fsel = __int_as_float(__builtin_amdgcn_ds_permute(dst * 4, __float_as_int(cand)));
      const int esel = __builtin_amdgcn_ds_permute(dst * 4, eid);
      const float f0 = __int_as_float(__builtin_amdgcn_readlane(__float_as_int(fsel), 0));
      float ev = ((lane & 3) == 0) ? __expf(fsel - f0) : 0.f;
      float es = ev;
      es += __shfl_xor(es, 4); es += __shfl_xor(es, 8); es += __shfl_xor(es, 16); es += __shfl_xor(es, 32);
      const float gate = ev / es;
      selw[h * 64] = u32x2{(uint32_t)esel, __float_as_uint(gate)};
      if (h == 0) {
#pragma unroll
        for (int k = 0; k < 16; k++) e[k] = __builtin_amdgcn_readlane(esel, (k & 1) * 32 + (k >> 1) * 4);
#pragma unroll
        for (int m = 0; m < 8; m++) {
          const u32x2* rp = (const u32x2*)(ubl + (size_t)(hi_half ? e[2 * m + 1] : e[2 * m]) * 1280);
          wu[m][0] = rp[0]; wu[m][1] = rp[1]; wu[m][2] = rp[2];
        }
#pragma unroll
        for (int m = 0; m < 8; m++) wv[m] = *(const u32x4*)(vbl + (size_t)(hi_half ? e[2 * m + 1] : e[2 * m]) * 1280);
      }
    }
    for (int h = 0; h < 8; h++) {
      float pd[8];
#pragma unroll
      for (int m = 0; m < 8; m++) {
        const u32x6 pk = {wu[m][0].x, wu[m][0].y, wu[m][1].x, wu[m][1].y, wu[m][2].x, wu[m][2].y};
        const f32x32 f = __builtin_amdgcn_cvt_scalef32_pk32_f32_fp6(pk, 1.0f);
        f32x2 a0 = {0.f, 0.f}, a1 = {0.f, 0.f};
#pragma unroll
        for (int i = 0; i < 8; i++) {
          a0 += f32x2{f[4 * i], f[4 * i + 1]} * f32x2{x[4 * i], x[4 * i + 1]};
          a1 += f32x2{f[4 * i + 2], f[4 * i + 3]} * f32x2{x[4 * i + 2], x[4 * i + 3]};
        }
        pd[m] = (a0.x + a0.y) + (a1.x + a1.y);
        __builtin_amdgcn_sched_barrier(0);
      }
      const float gate = __uint_as_float(selw[h * 64].y);
      if (h + 1 < 8) {
        const int esn = (int)selw[(h + 1) * 64].x;
#pragma unroll
        for (int k = 0; k < 16; k++) e[k] = __builtin_amdgcn_readlane(esn, (k & 1) * 32 + (k >> 1) * 4);
#pragma unroll
        for (int m = 0; m < 8; m++) {
          const u32x2* rp = (const u32x2*)(ubl + (size_t)(hi_half ? e[2 * m + 1] : e[2 * m]) * 1280);
          wu[m][0] = rp[0]; wu[m][1] = rp[1]; wu[m][2] = rp[2];
        }
      }
      __builtin_amdgcn_sched_barrier(0);
      float q4[4], q2[2], q1;
      {
        const bool hi = lane & 16;
#pragma unroll
        for (int k = 0; k < 4; k++) { const float give = hi ? pd[k] : pd[k + 4]; const float keep = hi ? pd[k + 4] : pd[k]; q4[k] = keep + __shfl_xor(give, 16); }
      }
      {
        const bool hi = lane & 8;
#pragma unroll
        for (int k = 0; k < 2; k++) { const float give = hi ? q4[k] : q4[k + 2]; const float keep = hi ? q4[k + 2] : q4[k]; q2[k] = keep + __shfl_xor(give, 8); }
      }
      {
        const bool hi = lane & 4;
        const float give = hi ? q2[0] : q2[1]; const float keep = hi ? q2[1] : q2[0];
        q1 = keep + __shfl_xor(give, 4);
      }
      q1 += __shfl_xor(q1, 2);
      q1 += __shfl_xor(q1, 1);
      const float aval = gate * gelu_exact(q1 * (1.0f / PEER_SU)) * (1.0f / PEER_SV);
      __builtin_amdgcn_sched_barrier(0);
#pragma unroll
      for (int m = 0; m < 8; m++) {
        const float alo = __int_as_float(__builtin_amdgcn_readlane(__float_as_int(aval), 4 * m));
        const float ahi = __int_as_float(__builtin_amdgcn_readlane(__float_as_int(aval), 32 + 4 * m));
        const float a = hi_half ? ahi : alo;
        const f32x2 a2 = {a, a};
#define FP4_ACC(WD, BS) { const f32x2 f = __builtin_amdgcn_cvt_scalef32_pk_f32_fp4(wv[m][WD], 1.0f, BS); \
          const f32x2 r = f32x2{y[2 * (WD * 4 + BS)], y[2 * (WD * 4 + BS) + 1]} + a2 * f; y[2 * (WD * 4 + BS)] = r.x; y[2 * (WD * 4 + BS) + 1] = r.y; }
#define FP4_ACC4(WD) FP4_ACC(WD, 0) FP4_ACC(WD, 1) FP4_ACC(WD, 2) FP4_ACC(WD, 3)
        FP4_ACC4(0) FP4_ACC4(1) FP4_ACC4(2) FP4_ACC4(3)
        __builtin_amdgcn_sched_barrier(0);
      }
      if (h + 1 < 8) {
#pragma unroll
        for (int m = 0; m < 8; m++) wv[m] = *(const u32x4*)(vbl + (size_t)(hi_half ? e[2 * m + 1] : e[2 * m]) * 1280);
      }
      __builtin_amdgcn_sched_barrier(0);
    }
    float sum = 0.f;
#pragma unroll
    for (int i = 0; i < 32; i++) { y[i] += __shfl_xor(y[i], 32); y[i] = fmaf(DN_ALPHA_F, x[i], y[i]); sum += y[i]; }
    sum += __shfl_xor(sum, 16); sum += __shfl_xor(sum, 8); sum += __shfl_xor(sum, 4); sum += __shfl_xor(sum, 2); sum += __shfl_xor(sum, 1);
    const float mu = sum * (1.0f / 1024.0f);
    float sq = 0.f;
#pragma unroll
    for (int i = 0; i < 32; i++) { const float d = y[i] - mu; sq += d * d; }
    sq += __shfl_xor(sq, 16); sq += __shfl_xor(sq, 8); sq += __shfl_xor(sq, 4); sq += __shfl_xor(sq, 2); sq += __shfl_xor(sq, 1);
    const float rs = rsqrtf(sq * (1.0f / 1024.0f) + LN_EPS_F);
    f32x4 ga[8], ba[8];
#pragma unroll
    for (int i = 0; i < 8; i++) { ga[i] = *(const f32x4*)(g2 + hl * 32 + i * 4); ba[i] = *(const f32x4*)(b2 + hl * 32 + i * 4); }
    f32x4 o[8];
#pragma unroll
    for (int i = 0; i < 8; i++) {
      o[i].x = (y[i * 4 + 0] - mu) * rs * ga[i].x + ba[i].x; o[i].y = (y[i * 4 + 1] - mu) * rs * ga[i].y + ba[i].y;
      o[i].z = (y[i * 4 + 2] - mu) * rs * ga[i].z + ba[i].z; o[i].w = (y[i * 4 + 3] - mu) * rs * ga[i].w + ba[i].w;
    }
    if (!hi_half) {
      if (layer == 3) {
#pragma unroll
        for (int i = 0; i < 8; i++) *(f32x4*)(xo + (size_t)tok * 1024 + hl * 32 + i * 4) = o[i];
      }
    } else if (layer != 3) {
#pragma unroll
      for (int i = 0; i < 4; i++) *(u32x4*)(p->xb + (size_t)tok * 1024 + hl * 32 + i * 8) = cvt8(o[2 * i], o[2 * i + 1]);
    }
  }
}

#define XB_TMO      128
#define XB_XCNT(j)  (256  + 64 * (j))
#define XB_XSUB(j)  (1280 + 64 * (j))
#define XB_XGEN(j)  (2304 + 64 * (j))
#define XB_TOP      3328
#define XB_TOPGEN   3392
#define XCD_BAR_WORDS 3456
#define XB_SPIN_CAP (1u << 18)
#define LAS __attribute__((address_space(3)))
__device__ __forceinline__ unsigned xb_ld(unsigned* p)              { return __hip_atomic_load(p, __ATOMIC_RELAXED, __HIP_MEMORY_SCOPE_AGENT); }
__device__ __forceinline__ unsigned xb_add(unsigned* p, unsigned v) { return __hip_atomic_fetch_add(p, v, __ATOMIC_RELAXED, __HIP_MEMORY_SCOPE_AGENT); }
__device__ __forceinline__ unsigned xb_xcc_id() { return (unsigned)__builtin_amdgcn_s_getreg((3 << 11) | 20) & 0xFu; }
#define XB_SPIN(cond, bar) do { unsigned _sp = 0; while (cond) { __builtin_amdgcn_s_sleep(1); \
    if ((++_sp & 255u) == 0u) { if (xb_ld(&(bar)[XB_TMO])) break; if (_sp > XB_SPIN_CAP) { atomicAdd(&(bar)[XB_TMO], 1u); break; } } } } while (0)
struct XcdBarrier { unsigned* bar; unsigned x; volatile LAS unsigned* st; };
__device__ __forceinline__ XcdBarrier xcd_barrier_post(unsigned* bar, volatile LAS unsigned* st) {
  XcdBarrier b; b.bar = bar; b.x = xb_xcc_id(); b.st = st;
  if (threadIdx.x == 0) (void)xb_add(&bar[XB_XCNT(b.x)], 1u);
  return b;
}
__device__ __forceinline__ void xcd_barrier_complete(unsigned* bar, unsigned x, unsigned& nloc, unsigned& nx) {
  const unsigned G = gridDim.x * gridDim.y * gridDim.z;
  unsigned sum, cnt, mine, sp = 0u;
  for (;;) {
    sum = 0u; cnt = 0u; mine = 0u;
#pragma unroll
    for (unsigned j = 0; j < 16; ++j) { const unsigned c = xb_ld(&bar[XB_XCNT(j)]); sum += c; cnt += (c > 0u) ? 1u : 0u; mine = (j == x) ? c : mine; }
    if (sum == G) break;
    __builtin_amdgcn_s_sleep(1);
    if ((++sp & 255u) == 0u) { if (xb_ld(&bar[XB_TMO])) break; if (sp > XB_SPIN_CAP) { atomicAdd(&bar[XB_TMO], 1u); break; } }
  }
  nloc = mine > 0u ? mine : 1u; nx = cnt > 0u ? cnt : 1u;
}
__device__ __forceinline__ void xcd_barrier(const XcdBarrier& b) {
  asm volatile("s_waitcnt vmcnt(0)" ::: "memory");
  __syncthreads();
  if (threadIdx.x == 0) {
    unsigned* bar = b.bar;
    __builtin_amdgcn_s_waitcnt(0);
    unsigned nloc = b.st[0], nx = b.st[1];
    if (nloc == 0u) { xcd_barrier_complete(bar, b.x, nloc, nx); b.st[0] = nloc; b.st[1] = nx; }
    const unsigned old = xb_add(&bar[XB_XSUB(b.x)], 1u);
    const unsigned gen = old / nloc;
    if (old + 1u == (gen + 1u) * nloc) {
      __builtin_amdgcn_fence(__ATOMIC_RELEASE, "agent");
      asm volatile("s_waitcnt vmcnt(0)" ::: "memory");
      const unsigned og = xb_add(&bar[XB_TOP], 1u);
      const unsigned tg = og / nx;
      if (og + 1u == (tg + 1u) * nx) xb_add(&bar[XB_TOPGEN], 1u);
      else XB_SPIN(xb_ld(&bar[XB_TOPGEN]) == tg, bar);
      __builtin_amdgcn_fence(__ATOMIC_ACQUIRE, "agent");
      xb_add(&bar[XB_XGEN(b.x)], 1u);
      asm volatile("s_waitcnt vmcnt(0)" ::: "memory");
    } else {
      XB_SPIN(xb_ld(&bar[XB_XGEN(b.x)]) == gen, bar);
      __builtin_amdgcn_fence(__ATOMIC_ACQUIRE, "agent");
      asm volatile("s_waitcnt vmcnt(0)" ::: "memory");
    }
  }
  __syncthreads();
}

__global__ void __launch_bounds__(256, 2) mega(Params p_arg, int ph_lo, int ph_hi, int coop) {
  __shared__ __attribute__((aligned(16))) unsigned char smem[SMEM_BYTES];
  __shared__ u32x4 xb_words;
  cg::grid_group grid = cg::this_grid();
  if (threadIdx.x == 0) xb_words = u32x4{0u, 0u, 0u, 0u};
  __syncthreads();
  if (coop) (void)xcd_barrier_post(((PP)__builtin_amdgcn_kernarg_segment_ptr())->bar, (volatile LAS unsigned*)&xb_words);
  for (int ph = ph_lo; ph < ph_hi; ph++) {
    const int reps = (int)((PROBE_MASK >> ph) & 1u) + 1;
    for (int rep = 0; rep < reps; rep++) {
      PP p = (PP)__builtin_amdgcn_kernarg_segment_ptr();
      asm volatile("" : "+s"(p));
      if (ph == 0) {
        phase_prologue(p, smem);
      } else {
        const int layer = (ph - 1) / 6, k = (ph - 1) % 6;
        switch (k) {
          case 0: phase_inproj(p, layer, smem); break;
          case 1: phase_mixer(p, layer, smem); break;
          case 2: phase_outproj(p, layer, smem); break;
          case 3: phase_ln1(p, layer); break;
          case 4: phase_peerq(p, layer, smem); break;
          default: phase_gather(p, layer, smem); break;
        }
      }
      if (coop == 1 && (rep + 1 < reps || ph + 1 < ph_hi)) {
        XcdBarrier xb; xb.bar = p->bar; xb.x = xb_xcc_id(); xb.st = (volatile LAS unsigned*)&xb_words;
        xcd_barrier(xb);
      }
      if (coop == 2) grid.sync();
    }
  }
}

extern "C" void kernel_launch(void* const* d_in, const int* in_sizes, int n_in, void* d_out, int out_size, void* d_ws,
                              size_t ws_size, hipStream_t stream) {
  Params p{};
  p.x_prompt = (const float*)d_in[0]; p.x_sample = (const float*)d_in[1];
  p.cache_swa_k = (const float*)d_in[2]; p.cache_swa_v = (const float*)d_in[3];
  p.cache_mem_k = (const float*)d_in[4]; p.cache_mem_v = (const float*)d_in[5];
  p.mem_prompt = (const float*)d_in[6];
  p.a_w_in = (const float*)d_in[7]; p.a_sink = (const float*)d_in[8]; p.b_w_in = (const float*)d_in[9];
  p.b_v_ln_g = (const float*)d_in[10]; p.b_v_ln_b = (const float*)d_in[11]; p.b_w_s = (const float*)d_in[12];
  p.b_b_s = (const float*)d_in[13]; p.w_mem_kv = (const float*)d_in[14]; p.w_out = (const float*)d_in[15];
  p.ln1_g = (const float*)d_in[16]; p.ln1_b = (const float*)d_in[17]; p.ln2_g = (const float*)d_in[18]; p.ln2_b = (const float*)d_in[19];
  p.peer_w_q = (const float*)d_in[20]; p.peer_b_q = (const float*)d_in[21]; p.peer_subkeys = (const float*)d_in[22];
  p.peer_u = (const float*)d_in[23]; p.peer_v = (const float*)d_in[24];
  float* o = (float*)d_out;
  p.y_out = o;                       o += (size_t)T_ALL * 1024;
  p.swa_k_prompt = o;                o += 131072;
  p.swa_v_prompt = o;                o += 131072;
  p.swa_k_sample = o;                o += 262144;
  p.swa_v_sample = o;                o += 262144;
  p.sg_v_sample = o;                 o += 786432;
  p.mem_k_prompt = o;                o += 524288;
  p.mem_v_prompt = o;
  unsigned char* wsb = (unsigned char*)d_ws;
  size_t off = 0;
  auto carve = [&](size_t bytes) { void* r = wsb + off; off += (bytes + 255) & ~(size_t)255; return r; };
  p.wT_a_in = (u16*)carve((size_t)2 * 1536 * 1024 * 2);
  p.wT_b_in = (u16*)carve((size_t)2 * 1792 * 1024 * 2);
  p.wT_memkv = (u16*)carve((size_t)4 * 512 * 1024 * 2);
  p.wT_out = (u16*)carve((size_t)4 * 1024 * 1024 * 2);
  p.wT_pq = (u16*)carve((size_t)4 * 2048 * 1024 * 2);
  p.subk = (u16*)carve((size_t)4 * 8 * 2 * 128 * 128 * 2);
  p.ub = (unsigned char*)carve((size_t)4 * 16384 * 1280);
  p.vb = p.ub;
  p.memb = (u16*)carve((size_t)512 * 1024 * 2);
  p.xb = (u16*)carve((size_t)T_ALL * 1024 * 2);
  p.z = (u16*)carve((size_t)T_ALL * ZLD * 2);
  p.mix = (u16*)carve((size_t)T_ALL * 1024 * 2);
  p.mkvp = (u16*)carve((size_t)4 * 2 * 512 * 256 * 2);
  p.preb = (u16*)carve((size_t)T_ALL * 1024 * 2);
  p.ropecs = (float*)carve((size_t)8196 * 8 * 2 * 4);
  p.topk = (uint32_t*)carve((size_t)T_ALL * 16 * 16 * 4);
  p.bar = (unsigned*)carve((size_t)XCD_BAR_WORDS * 4);
  if (off > ws_size) { fprintf(stderr, "workspace too small: need %zu have %zu\n", off, ws_size); return; }

  static int grid_blocks = 0;
  if (!grid_blocks) {
    int dev = 0, cus = 0, per_cu = 0;
    (void)hipGetDevice(&dev);
    (void)hipDeviceGetAttribute(&cus, hipDeviceAttributeMultiprocessorCount, dev);
    (void)hipOccupancyMaxActiveBlocksPerMultiprocessor(&per_cu, mega, 256, 0);
    if (per_cu < 1) per_cu = 1;
    if (per_cu > 2) per_cu = 2;
    grid_blocks = cus * per_cu;
  }
#if MK_MULTI
  for (int ph = 0; ph < N_PHASES; ph++) mega<<<dim3(grid_blocks), dim3(256), 0, stream>>>(p, ph, ph + 1, 0);
#else
  (void)hipMemsetAsync(p.bar, 0, (size_t)XCD_BAR_WORDS * 4, stream);
  int lo = 0, hi = N_PHASES, coop = 1;
  void* args[] = {&p, &lo, &hi, &coop};
  hipError_t e = hipLaunchCooperativeKernel((void*)mega, dim3(grid_blocks), dim3(256), args, 0, stream);
  if (e != hipSuccess) fprintf(stderr, "cooperative launch failed: %s (grid %d)\n", hipGetErrorString(e), grid_blocks);
#endif
}
```
